# Optimizing an MI355X kernel written in HIP

```python
import math
import jax, jax.numpy as jnp
from jax import lax
import numpy as np

D_MODEL = 1024
BATCH = 8
SEQ = 2048
DEPTH = 4

CHUNK = 64
N_A_LAYERS = DEPTH // 2
N_B_LAYERS = DEPTH - N_A_LAYERS
A_HEADS = 4
A_DV = D_MODEL // A_HEADS
A_DQK = A_DV // 2
A_QK_W = A_HEADS * A_DQK
A_V_W = A_HEADS * A_DV
A_PROJ = 2 * A_QK_W + 2 * A_V_W + 2 * A_HEADS
B_HEADS = 16
B_DH = D_MODEL // B_HEADS
B_KV_PROJ = 2 * D_MODEL + B_HEADS
Q_BLOCK = 128
D_FF = 4 * D_MODEL
EPS = 1e-6

kernel_name = "yoco_mlstm_fox_adaln_encoder"


def rms_norm(x, gain=None):
    xf = x.astype(jnp.float32)
    y = xf * lax.rsqrt(jnp.mean(xf * xf, axis=-1, keepdims=True) + EPS)
    if gain is not None:
        y = y * gain.astype(jnp.float32)
    return y.astype(x.dtype)


def modulate(x, shift, scale):
    return rms_norm(x) * (1 + scale[:, None, :]) + shift[:, None, :]


def mlstm_chunkwise(q, k, v, i_pre, logf):
    B, H, S, DQK = q.shape
    DV = v.shape[-1]
    nc = S // CHUNK

    def chunks(t):
        return jnp.moveaxis(t.reshape(B, H, nc, CHUNK, *t.shape[3:]), 2, 0)

    causal = jnp.asarray(np.tril(np.ones((CHUNK, CHUNK), dtype=bool)))

    def step(carry, xs):
        C, n, m = carry
        qc, kc, vc, ic, fc = xs
        b = jnp.cumsum(fc, axis=-1)
        d = b[..., :, None] - b[..., None, :] + ic[..., None, :]
        d = jnp.where(causal, d, -jnp.inf)
        inter = b + m[..., None]
        m_t = jnp.maximum(inter, jnp.max(d, axis=-1))
        w = jnp.exp(d - m_t[..., None])
        w_inter = jnp.exp(inter - m_t)
        a = w * jnp.einsum('bhtd,bhsd->bhts', qc, kc)
        num = (w_inter[..., None] * jnp.einsum('bhtd,bhde->bhte', qc, C)
               + jnp.einsum('bhts,bhse->bhte', a, vc))
        den = w_inter * jnp.einsum('bhtd,bhd->bht', qc, n) + jnp.sum(a, axis=-1)
        h = num / jnp.maximum(jnp.abs(den), jnp.exp(-m_t))[..., None]
        bL = b[..., -1]
        dl = bL[..., None] - b + ic
        m_new = jnp.maximum(bL + m, jnp.max(dl, axis=-1))
        wl = jnp.exp(dl - m_new[..., None])
        decay = jnp.exp(bL + m - m_new)
        C_new = decay[..., None, None] * C + jnp.einsum('bhs,bhsd,bhse->bhde', wl, kc, vc)
        n_new = decay[..., None] * n + jnp.einsum('bhs,bhsd->bhd', wl, kc)
        return (C_new, n_new, m_new), h

    init = (jnp.zeros((B, H, DQK, DV), jnp.float32),
            jnp.zeros((B, H, DQK), jnp.float32),
            jnp.zeros((B, H), jnp.float32))
    _, hs = lax.scan(step, init, (chunks(q), chunks(k), chunks(v), chunks(i_pre), chunks(logf)))
    return jnp.moveaxis(hs, 0, 2).reshape(B, H, S, DV)


def mlstm_mixer(h, w_in, b_i, b_f, head_gain, w_out):
    B, S, _ = h.shape
    proj = h @ w_in
    q, k, v, o, ig, fg = jnp.split(
        proj, [A_QK_W, 2 * A_QK_W, 2 * A_QK_W + A_V_W, 2 * A_QK_W + 2 * A_V_W,
               2 * A_QK_W + 2 * A_V_W + A_HEADS], axis=-1)
    q = q.reshape(B, S, A_HEADS, A_DQK).transpose(0, 2, 1, 3).astype(jnp.float32) * (A_DQK ** -0.5)
    k = k.reshape(B, S, A_HEADS, A_DQK).transpose(0, 2, 1, 3).astype(jnp.float32)
    v = v.reshape(B, S, A_HEADS, A_DV).transpose(0, 2, 1, 3).astype(jnp.float32)
    i_pre = (ig + b_i).astype(jnp.float32).transpose(0, 2, 1)
    logf = jax.nn.log_sigmoid((fg + b_f).astype(jnp.float32)).transpose(0, 2, 1)
    ht = mlstm_chunkwise(q, k, v, i_pre, logf)
    ht = ht * lax.rsqrt(jnp.mean(ht * ht, axis=-1, keepdims=True) + EPS)
    ht = ht * head_gain.astype(jnp.float32)[None, :, None, :]
    ht = ht.transpose(0, 2, 1, 3).reshape(B, S, A_V_W).astype(h.dtype)
    return (jax.nn.sigmoid(o) * ht) @ w_out


def fox_shared_kv(x, kv_gain, w_kv, fg_bias):
    B, S, _ = x.shape
    proj = rms_norm(x, kv_gain) @ w_kv
    k, v, fg = jnp.split(proj, [D_MODEL, 2 * D_MODEL], axis=-1)
    k = k.reshape(B, S, B_HEADS, B_DH).transpose(0, 2, 1, 3)
    v = v.reshape(B, S, B_HEADS, B_DH).transpose(0, 2, 1, 3)
    logf = jax.nn.log_sigmoid((fg + fg_bias).astype(jnp.float32)).transpose(0, 2, 1)
    F = jnp.cumsum(logf, axis=-1)
    return k, v, F


def fox_attention(q, k, v, F):
    S = q.shape[2]
    scale = B_DH ** -0.5
    outs = []
    for blk in range(S // Q_BLOCK):
        lo, hi = blk * Q_BLOCK, (blk + 1) * Q_BLOCK
        kb, vb = k[:, :, :hi], v[:, :, :hi]
        s = (jnp.einsum('bhtd,bhsd->bhts', q[:, :, lo:hi], kb).astype(jnp.float32) * scale
             + F[:, :, lo:hi, None] - F[:, :, None, :hi])
        mask = (lo + np.arange(Q_BLOCK))[:, None] >= np.arange(hi)[None, :]
        p = jax.nn.softmax(jnp.where(mask, s, -jnp.inf), axis=-1)
        outs.append(jnp.einsum('bhts,bhsd->bhtd', p.astype(vb.dtype), vb))
    return jnp.concatenate(outs, axis=2)


def fox_mixer(h, w_q, w_out, k, v, F):
    B, S, _ = h.shape
    q = (h @ w_q).reshape(B, S, B_HEADS, B_DH).transpose(0, 2, 1, 3)
    o = fox_attention(q, k, v, F)
    return o.transpose(0, 2, 1, 3).reshape(B, S, D_MODEL) @ w_out


def squared_relu_mlp(h, w1, w2):
    return jnp.square(jax.nn.relu(h @ w1)) @ w2


def setup_inputs(seed: int = 0) -> dict:
    key = jax.random.key(seed)
    ks = jax.random.split(key, 17)
    f32 = jnp.float32
    nrm = lambda k, shape: jax.random.normal(k, shape, f32)
    d = D_MODEL
    return {
        "x": nrm(ks[0], (BATCH, SEQ, d)),
        "c": nrm(ks[1], (BATCH, d)),
        "ada_w": nrm(ks[2], (DEPTH, d, 6 * d)) * (0.5 * d ** -0.5),
        "ada_b": nrm(ks[3], (DEPTH, 6 * d)) * 0.02,
        "a_w_in": nrm(ks[4], (N_A_LAYERS, d, A_PROJ)) * d ** -0.5,
        "a_b_i": nrm(ks[5], (N_A_LAYERS, A_HEADS)) * 0.1,
        "a_b_f": jnp.linspace(3.0, 6.0, A_HEADS, dtype=f32)[None, :] + 0.1 * nrm(ks[6], (N_A_LAYERS, A_HEADS)),
        "a_head_gain": 1.0 + 0.02 * nrm(ks[7], (N_A_LAYERS, A_HEADS, A_DV)),
        "a_w_out": nrm(ks[8], (N_A_LAYERS, A_V_W, d)) * A_V_W ** -0.5,
        "kv_gain": 1.0 + 0.02 * nrm(ks[9], (d,)),
        "b_w_kv": nrm(ks[10], (d, B_KV_PROJ)) * d ** -0.5,
        "b_fg_bias": jnp.linspace(1.0, 5.0, B_HEADS, dtype=f32) + 0.1 * nrm(ks[11], (B_HEADS,)),
        "b_w_q": nrm(ks[12], (N_B_LAYERS, d, d)) * d ** -0.5,
        "b_w_out": nrm(ks[13], (N_B_LAYERS, d, d)) * d ** -0.5,
        "mlp_w1": nrm(ks[14], (DEPTH, d, D_FF)) * d ** -0.5,
        "mlp_w2": nrm(ks[15], (DEPTH, D_FF, d)) * D_FF ** -0.5,
        "final_gain": 1.0 + 0.02 * nrm(ks[16], (d,)),
    }


def reference(x, c, ada_w, ada_b, a_w_in, a_b_i, a_b_f, a_head_gain, a_w_out,
              kv_gain, b_w_kv, b_fg_bias, b_w_q, b_w_out, mlp_w1, mlp_w2, final_gain):
    cond = jax.nn.silu(c)
    shared = None
    for l in range(DEPTH):
        mod = cond @ ada_w[l] + ada_b[l]
        sh1, sc1, g1, sh2, sc2, g2 = jnp.split(mod, 6, axis=-1)
        h = modulate(x, sh1, sc1)
        if l < N_A_LAYERS:
            y = mlstm_mixer(h, a_w_in[l], a_b_i[l], a_b_f[l], a_head_gain[l], a_w_out[l])
        else:
            if shared is None:
                shared = fox_shared_kv(x, kv_gain, b_w_kv, b_fg_bias)
            j = l - N_A_LAYERS
            y = fox_mixer(h, b_w_q[j], b_w_out[j], *shared)
        x = x + g1[:, None, :] * y
        h = modulate(x, sh2, sc2)
        x = x + g2[:, None, :] * squared_relu_mlp(h, mlp_w1[l], mlp_w2[l])
    return rms_norm(x, final_gain)
```

```cpp
#include <hip/hip_runtime.h>
#include <hip/hip_cooperative_groups.h>
#include <cstdio>
#include <cstdint>
namespace cg = cooperative_groups;
namespace pg8 {
#define PG8_LAS __attribute__((address_space(3)))
typedef unsigned short bf16_t;
typedef short bf16x8 __attribute__((ext_vector_type(8)));
typedef float f32x4 __attribute__((ext_vector_type(4)));
typedef unsigned u32x4 __attribute__((ext_vector_type(4)));
constexpr int BM = 256, BK = 64, HALF = 128, HTB = HALF * BK * 2  , STAGE_BYTES = 8 * HTB, NXCD = 8, WGM = 8;

__host__ __device__ __forceinline__ int lds_byte(int r, int c) { const int st = (r >> 4) * 2 + (c >> 5), rr = r & 15, cc = c & 31, ob = rr * 64 + cc * 2; return st * 1024 + (ob ^ (((ob >> 9) & 1) << 5)); }
__host__ __device__ __forceinline__ void stage_rc(int b, int& R, int& C) { const int st = b / 1024, sb = b % 1024, swz = sb ^ (((sb >> 9) & 1) << 5); R = (st >> 1) * 16 + swz / 64; C = (st & 1) * 32 + (swz % 64) / 2; }
__host__ __device__ __forceinline__ int perm32(int rho) { const int n = rho >> 4, i = rho & 15; return 8 * (i >> 2) + 4 * n + (i & 3); }

struct Unit { int pm, pn; };
struct Gemm { const bf16_t* A; const bf16_t* Bt; int M, N, K; };

struct StaticOrder {
    int nM, nN, nwg, G, c;
    __host__ __device__ void init(int M, int N, int G_, int c_) { nM = M / BM; nN = N / BM; nwg = nM * nN; G = G_; c = c_; }
    __host__ __device__ bool next(int i, Unit& u) const {
        const long L = (long)i * G + c; if (L >= nwg) return false;
        int wgid = (int)L; { const int q = nwg / NXCD, r = nwg % NXCD, xcd = wgid % NXCD, off = wgid / NXCD; wgid = (xcd < r ? xcd * (q + 1) : r * (q + 1) + (xcd - r) * q) + off; }
        const int nig = WGM * nN, gid = wgid / nig, fm = gid * WGM, gsz = (nM - fm) < WGM ? (nM - fm) : WGM;
        u.pm = fm + ((wgid % nig) % gsz); u.pn = (wgid % nig) / gsz; return true;
    }
    __device__ __forceinline__ void a_ready(const Unit&) const {}
    __device__ __forceinline__ void done(const Unit&) const {}
};

__device__ __forceinline__ unsigned cvt_pk_bf16(float lo, float hi) { unsigned r; asm volatile("v_cvt_pk_bf16_f32 %0, %1, %2" : "=v"(r) : "v"(lo), "v"(hi)); return r; }
template <int KIND> struct EpiStore {
    static constexpr bool PERM = true, AFTER_DRAIN = false;
    bf16_t *P0, *P1, *P2, *P3; float s0;
    __device__ __forceinline__ void operator()(const f32x4 (&acc)[2][2][4][2], const Unit& u, int wr, int wc, int fr, int fq) const {
        bf16_t* base = P0; int ldc = 1024, colt = u.pn * BM; float sc = 1.f; int act = 0;
        if (KIND == 0) { const int pn = u.pn;
            if (pn < 2) { base = P0; ldc = 512; colt = pn * BM; sc = s0; }
            else if (pn < 4) { base = P1; ldc = 512; colt = (pn - 2) * BM; }
            else if (pn < 8) { base = P2; ldc = 1024; colt = (pn - 4) * BM; }
            else { base = P3; ldc = 1024; colt = (pn - 8) * BM; act = 1; } }
        else if (KIND == 1) { sc = s0; }
        else if (KIND == 2) { if (u.pn >= 4) { base = P1; colt = (u.pn - 4) * BM; } }
        else { ldc = 4096; act = 2; }
        const int row0 = u.pm * BM + wr * 64 + fr, col0 = colt + wc * 32 + 8 * fq;
#pragma unroll
        for (int ai = 0; ai < 2; ++ai)
#pragma unroll
            for (int m = 0; m < 4; ++m) { bf16_t* rowp = base + (size_t)(row0 + ai * HALF + m * 16) * ldc + col0;
#pragma unroll
                for (int bj = 0; bj < 2; ++bj) { f32x4 v0 = acc[ai][bj][m][0], v1 = acc[ai][bj][m][1];
                    if (act == 1) {
#pragma unroll
                        for (int i = 0; i < 4; ++i) { v0[i] = __builtin_amdgcn_rcpf(1.0f + __expf(-v0[i])); v1[i] = __builtin_amdgcn_rcpf(1.0f + __expf(-v1[i])); } }
                    if (act == 2) {
#pragma unroll
                        for (int i = 0; i < 4; ++i) { const float a = fmaxf(v0[i], 0.f), b = fmaxf(v1[i], 0.f); v0[i] = a * a; v1[i] = b * b; } }
                    v0 = v0 * sc; v1 = v1 * sc; u32x4 w; w.x = cvt_pk_bf16(v0[0], v0[1]); w.y = cvt_pk_bf16(v0[2], v0[3]); w.z = cvt_pk_bf16(v1[0], v1[1]); w.w = cvt_pk_bf16(v1[2], v1[3]);
                    *(u32x4*)(rowp + bj * HALF) = w; } }
    }
};
struct EpiRes {
    static constexpr bool PERM = true, AFTER_DRAIN = false;
    float* X; const float* gate;
    __device__ __forceinline__ void operator()(const f32x4 (&acc)[2][2][4][2], const Unit& u, int wr, int wc, int fr, int fq) const {
        const float* g = gate + (size_t)(u.pm >> 3) * 6144;
        const int row0 = u.pm * BM + wr * 64 + fr, col0 = u.pn * BM + wc * 32 + 8 * fq;
        f32x4 gv[2][2];
#pragma unroll
        for (int bj = 0; bj < 2; ++bj)
#pragma unroll
            for (int n = 0; n < 2; ++n) gv[bj][n] = *(const f32x4*)(g + col0 + bj * HALF + 4 * n);
#pragma unroll
        for (int ai = 0; ai < 2; ++ai)
#pragma unroll
            for (int m = 0; m < 4; ++m) { float* rowp = X + (size_t)(row0 + ai * HALF + m * 16) * 1024 + col0;
#pragma unroll
                for (int bj = 0; bj < 2; ++bj) { f32x4 x0 = *(const f32x4*)(rowp + bj * HALF), x1 = *(const f32x4*)(rowp + bj * HALF + 4);
                    x0 = x0 + gv[bj][0] * acc[ai][bj][m][0]; x1 = x1 + gv[bj][1] * acc[ai][bj][m][1];
                    *(f32x4*)(rowp + bj * HALF) = x0; *(f32x4*)(rowp + bj * HALF + 4) = x1; }
                asm volatile("" ::: "memory"); }
    }
};
template <class Epi, class Sched, bool ALIGN_EPI = false, bool SP2 = false>
__device__ __forceinline__ void gemm_phase(PG8_LAS unsigned char* lds, const Gemm g, const Sched& S, const Epi& E) {
    int zz_ = 0; asm volatile("" : "+s"(zz_)); const int tid = threadIdx.x + __builtin_amdgcn_readfirstlane(zz_), wid = __builtin_amdgcn_readfirstlane(tid >> 6), lane = tid & 63, wr = wid >> 2, wc = wid & 3, fr = lane & 15, fq = lane >> 4;
    const int K = g.K, nt = K / BK;
    unsigned voffA[2], voffB[2];
#pragma unroll
    for (int i = 0; i < 2; ++i) { int R, C; stage_rc(tid * 16 + i * 8192, R, C); const int Rb = Epi::PERM ? ((R & ~31) + perm32(R & 31)) : R;
        voffA[i] = (unsigned)(R * K + C) * 2u; voffB[i] = (unsigned)(Rb * K + C) * 2u; }
    const size_t kstep = (size_t)(BK * 2);
    const size_t hstep = (size_t)HALF * K * 2;
    const size_t tstep = 2 * hstep;
    const unsigned ldsw = (unsigned)wid * 1024u;
    const int aoff = lds_byte(wr * 64 + fr, fq * 8), boff = lds_byte(wc * 32 + fr, fq * 8);
#define PG8_SA(b, h) (((b) * 2 + (h)) * HTB)
#define PG8_SB(b, h) ((4 + (b) * 2 + (h)) * HTB)
#define PG8_STAGE(bufoff, gbase, voff) do { _Pragma("unroll") for (int _i = 0; _i < 2; ++_i) \
        __builtin_amdgcn_global_load_lds((const unsigned*)((const char*)(gbase) + (voff)[_i]), (PG8_LAS unsigned*)(lds + (bufoff) + ldsw + _i * 8192), 16, 0, 0); } while (0)
#define PG8_LDA(dst, b, h) do { _Pragma("unroll") for (int m = 0; m < 4; ++m) _Pragma("unroll") for (int k = 0; k < 2; ++k) dst[m][k] = *(const PG8_LAS bf16x8*)(lds + PG8_SA(b, h) + aoff + m * 2048 + k * 1024); } while (0)
#define PG8_LDB(dst, b, h) do { _Pragma("unroll") for (int n = 0; n < 2; ++n) _Pragma("unroll") for (int k = 0; k < 2; ++k) dst[n][k] = *(const PG8_LAS bf16x8*)(lds + PG8_SB(b, h) + boff + n * 2048 + k * 1024); } while (0)
#define PG8_MMA(ai, bj, At, Bt) do { __builtin_amdgcn_s_setprio(1); _Pragma("unroll") for (int m = 0; m < 4; ++m) _Pragma("unroll") for (int n = 0; n < 2; ++n) _Pragma("unroll") for (int k = 0; k < 2; ++k) \
        acc[ai][bj][m][n] = __builtin_amdgcn_mfma_f32_16x16x32_bf16(Bt[n][k], At[m][k], acc[ai][bj][m][n], 0, 0, 0); __builtin_amdgcn_s_setprio(0); } while (0)
#define PG8_WAIT_V(n) asm volatile("s_waitcnt vmcnt(" #n ")" ::: "memory")
#define PG8_WAIT_L(n) asm volatile("s_waitcnt lgkmcnt(" #n ")" ::: "memory")
#define PG8_BAR __builtin_amdgcn_s_barrier()
#define PG8_SCHED __builtin_amdgcn_sched_barrier(0)
    Unit cur, nxt; int ui = 0;
    if (!S.next(0, cur)) return;
    f32x4 acc[2][2][4][2];
#pragma unroll
    for (int a = 0; a < 2; ++a)
#pragma unroll
        for (int b = 0; b < 2; ++b)
#pragma unroll
            for (int m = 0; m < 4; ++m)
#pragma unroll
                for (int n = 0; n < 2; ++n) acc[a][b][m][n] = (f32x4){0.f, 0.f, 0.f, 0.f};
    bf16x8 At[4][2], B0[2][2], B1[2][2];
    const char* cA = (const char*)g.A + (size_t)cur.pm * tstep; const char* cB = (const char*)g.Bt + (size_t)cur.pn * tstep;
    S.a_ready(cur);
    if constexpr (SP2) {
        PG8_STAGE(PG8_SB(0, 0), cB, voffB); PG8_STAGE(PG8_SB(0, 1), cB + hstep, voffB); PG8_STAGE(PG8_SA(0, 0), cA, voffA); PG8_STAGE(PG8_SA(0, 1), cA + hstep, voffA);
        if (wr == 1) PG8_BAR;
        PG8_WAIT_V(2); PG8_BAR;
        PG8_STAGE(PG8_SB(1, 0), cB + kstep, voffB); PG8_STAGE(PG8_SA(1, 0), cA + kstep, voffA); PG8_STAGE(PG8_SB(1, 1), cB + hstep + kstep, voffB);
        PG8_WAIT_V(6); PG8_BAR;
    } else {
        PG8_STAGE(PG8_SB(0, 0), cB, voffB); PG8_STAGE(PG8_SA(0, 0), cA, voffA); PG8_STAGE(PG8_SB(0, 1), cB + hstep, voffB); PG8_STAGE(PG8_SA(0, 1), cA + hstep, voffA);
        if (wr == 1) PG8_BAR;
        PG8_WAIT_V(4); PG8_BAR;
        PG8_STAGE(PG8_SB(1, 0), cB + kstep, voffB); PG8_STAGE(PG8_SA(1, 0), cA + kstep, voffA); PG8_STAGE(PG8_SB(1, 1), cB + hstep + kstep, voffB);
        PG8_WAIT_V(6); PG8_BAR;
    }
    for (;;) {
        const bool has_next = S.next(ui + 1, nxt);
        const char* nA = has_next ? (const char*)g.A + (size_t)nxt.pm * tstep : cA; const char* nB = has_next ? (const char*)g.Bt + (size_t)nxt.pn * tstep : cB;
        for (int t = 0; t < nt; t += 2) {
            const bool last = (t == nt - 2);
            const char* a1 = cA + (size_t)(t + 1) * kstep;
            const char* a2 = last ? nA : cA + (size_t)(t + 2) * kstep; const char* b2 = last ? nB : cB + (size_t)(t + 2) * kstep;
            const char* a3 = a2 + kstep; const char* b3 = b2 + kstep;
            if (last && has_next) S.a_ready(nxt);
            if constexpr (SP2) {
            PG8_LDB(B0, 0, 0); PG8_LDB(B1, 0, 1); PG8_SCHED; PG8_LDA(At, 0, 0); PG8_STAGE(PG8_SA(1, 1), a1 + hstep, voffA);
            PG8_WAIT_V(8); PG8_WAIT_L(0); PG8_BAR; PG8_MMA(0, 0, At, B0); PG8_MMA(0, 1, At, B1); PG8_BAR; PG8_SCHED;
            PG8_LDA(At, 0, 1); PG8_STAGE(PG8_SB(0, 0), b2, voffB); PG8_STAGE(PG8_SB(0, 1), b2 + hstep, voffB); PG8_STAGE(PG8_SA(0, 0), a2, voffA);
            PG8_WAIT_V(8); PG8_WAIT_L(0); PG8_BAR; PG8_MMA(1, 0, At, B0); PG8_MMA(1, 1, At, B1); PG8_BAR; PG8_SCHED;
            PG8_LDB(B0, 1, 0); PG8_LDB(B1, 1, 1); PG8_SCHED; PG8_LDA(At, 1, 0); PG8_STAGE(PG8_SA(0, 1), a2 + hstep, voffA);
            PG8_WAIT_V(8); PG8_WAIT_L(0); PG8_BAR; PG8_MMA(0, 0, At, B0); PG8_MMA(0, 1, At, B1); PG8_BAR; PG8_SCHED;
            PG8_LDA(At, 1, 1); PG8_STAGE(PG8_SB(1, 0), b3, voffB); PG8_STAGE(PG8_SB(1, 1), b3 + hstep, voffB); PG8_STAGE(PG8_SA(1, 0), a3, voffA);
            PG8_WAIT_V(8); PG8_WAIT_L(0); PG8_BAR; PG8_MMA(1, 0, At, B0); PG8_MMA(1, 1, At, B1); PG8_BAR; PG8_SCHED;
            } else {
            PG8_LDB(B0, 0, 0); PG8_SCHED; PG8_LDA(At, 0, 0); PG8_STAGE(PG8_SA(1, 1), a1 + hstep, voffA);
            PG8_WAIT_L(8); PG8_BAR; PG8_WAIT_L(0); PG8_MMA(0, 0, At, B0); PG8_BAR; PG8_SCHED;
            PG8_LDB(B1, 0, 1); PG8_STAGE(PG8_SB(0, 0), b2, voffB);
            PG8_BAR; PG8_WAIT_L(0); PG8_MMA(0, 1, At, B1); PG8_BAR;
            PG8_LDA(At, 0, 1); PG8_STAGE(PG8_SA(0, 0), a2, voffA);
            PG8_BAR; PG8_WAIT_L(0); PG8_MMA(1, 0, At, B0); PG8_BAR; PG8_SCHED;
            PG8_STAGE(PG8_SB(0, 1), b2 + hstep, voffB);
            PG8_WAIT_V(6); PG8_BAR; PG8_MMA(1, 1, At, B1); PG8_BAR;
            PG8_LDB(B0, 1, 0); PG8_SCHED; PG8_LDA(At, 1, 0); PG8_STAGE(PG8_SA(0, 1), a2 + hstep, voffA);
            PG8_WAIT_L(8); PG8_BAR; PG8_WAIT_L(0); PG8_MMA(0, 0, At, B0); PG8_BAR; PG8_SCHED;
            PG8_LDB(B1, 1, 1); PG8_STAGE(PG8_SB(1, 0), b3, voffB);
            PG8_BAR; PG8_WAIT_L(0); PG8_MMA(0, 1, At, B1); PG8_BAR;
            PG8_LDA(At, 1, 1); PG8_STAGE(PG8_SA(1, 0), a3, voffA);
            PG8_BAR; PG8_WAIT_L(0); PG8_MMA(1, 0, At, B0); PG8_BAR; PG8_SCHED;
            PG8_STAGE(PG8_SB(1, 1), b3 + hstep, voffB);
            PG8_WAIT_V(6); PG8_BAR; PG8_MMA(1, 1, At, B1); PG8_BAR;
            }
        }
        if constexpr (ALIGN_EPI) { if (wr == 0) PG8_BAR; }
        if constexpr (!Epi::AFTER_DRAIN) { E(acc, cur, wr, wc, fr, fq); S.done(cur); }
        if (!has_next) break;
#pragma unroll
        for (int a = 0; a < 2; ++a)
#pragma unroll
            for (int b = 0; b < 2; ++b)
#pragma unroll
                for (int m = 0; m < 4; ++m)
#pragma unroll
                    for (int n = 0; n < 2; ++n) acc[a][b][m][n] = (f32x4){0.f, 0.f, 0.f, 0.f};
        cur = nxt; cA = nA; cB = nB; ++ui;
        if constexpr (ALIGN_EPI) { if (wr == 1) PG8_BAR; }
    }
    PG8_WAIT_V(0);
    if constexpr (!ALIGN_EPI) { if (wr == 0) PG8_BAR; }
    PG8_BAR;
    if constexpr (Epi::AFTER_DRAIN) { E.fused(acc, cur, wr, wc, fr, fq, lds, wid, lane); S.done(cur); }
#undef PG8_SA
#undef PG8_SB
#undef PG8_STAGE
#undef PG8_LDA
#undef PG8_LDB
#undef PG8_MMA
#undef PG8_WAIT_V
#undef PG8_WAIT_L
#undef PG8_BAR
#undef PG8_SCHED
}
}
#ifndef PG8_SP2
#define PG8_SP2 true
#endif
#include <hip/hip_bf16.h>
#include <cmath>
namespace attn_body {
using bf16=__hip_bfloat16;
using bf16x8=__attribute__((ext_vector_type(8)))short;
using s16x4=__attribute__((ext_vector_type(4)))short;
using f32x16=__attribute__((ext_vector_type(16)))float;
using u32x4=__attribute__((ext_vector_type(4)))unsigned;
using f32x4_t=__attribute__((ext_vector_type(4)))float;
constexpr int BATCH=8,NHEAD=16,SEQ=2048,D=64,DM=NHEAD*D;
constexpr int NW=8,QBLK=32,QB=QBLK*NW,KVBLK=64,NQB=SEQ/QB;
constexpr int ATTN_PITCH=DM, ATTN_UNIT_ROWS=QB;
__device__ __forceinline__ int crow(int r,int hi){return (r&3)+8*(r>>2)+4*hi;}
#define SBAR() __builtin_amdgcn_sched_barrier(0)
__device__ __forceinline__ void cmask(f32x16&p0,f32x16&p1,int jb,int qrel,int hi){
  const float NEG=-INFINITY; int kb=64*jb+4*hi;
  #pragma unroll
  for(int r=0;r<16;++r){int kv=kb+(r&3)+8*(r>>2); if(kv>qrel)p0[r]=NEG; if(kv+32>qrel)p1[r]=NEG;}
}

constexpr int NSLOT=3, SLOTB=8192;
constexpr int LDS_K=0, LDS_V=NSLOT*SLOTB, LDS_WS=2*NSLOT*SLOTB, LDS_OST=LDS_WS+NW*64*4, LDS_BIAS=LDS_OST+NW*4096, LDS_BYTES=LDS_BIAS+8192;
constexpr float C2=0.125f*1.4426950408889634f;
__device__ __forceinline__ void glds16(const void*gsrc,unsigned lds_dst){unsigned keep;
  asm volatile("s_mov_b32 %0, m0\n\ts_mov_b32 m0, %2\n\ts_nop 0\n\tglobal_load_lds_dwordx4 %1, off\n\ts_mov_b32 m0, %0":"=&s"(keep):"v"(gsrc),"s"(lds_dst):"memory");}
__device__ __forceinline__ float max3f(float a,float b,float c){float r;asm("v_max3_f32 %0, %1, %2, %3":"=v"(r):"v"(a),"v"(b),"v"(c));return r;}
__device__ __forceinline__ float max2f(float a,float b){float r;asm("v_max_f32_e32 %0, %1, %2":"=v"(r):"v"(a),"v"(b));return r;}
__device__ __forceinline__ float fadd_s(float a,float b){float r;asm("v_add_f32_e32 %0, %1, %2":"=v"(r):"v"(a),"v"(b));return r;}
__device__ __forceinline__ float fsub_s(float a,float b){float r;asm("v_sub_f32_e32 %0, %1, %2":"=v"(r):"v"(a),"v"(b));return r;}
typedef float f32x2_t __attribute__((ext_vector_type(2))); typedef __bf16 bf16x2_t __attribute__((ext_vector_type(2)));
__device__ __forceinline__ unsigned cvtpk_s(float lo,float hi){f32x2_t v={lo,hi};bf16x2_t b=__builtin_convertvector(v,bf16x2_t);return __builtin_bit_cast(unsigned,b);}
#define WAIT_BAR(N) asm volatile("s_waitcnt vmcnt(" #N ") lgkmcnt(0)\n\ts_barrier":::"memory")

__device__ __forceinline__ void qkt(f32x16&p0,f32x16&p1,const char*Kslot,const bf16x8*qr,int r32,int hi){
  const char*kb=Kslot+hi*1024+r32*16;
  #pragma unroll
  for(int d0=0;d0<4;++d0){
    const bf16x8 b0=*reinterpret_cast<const bf16x8*>(kb+d0*2048);
    const bf16x8 b1=*reinterpret_cast<const bf16x8*>(kb+d0*2048+512);
    p0=__builtin_amdgcn_mfma_f32_32x32x16_bf16(b0,qr[d0],p0,0,0,0);p1=__builtin_amdgcn_mfma_f32_32x32x16_bf16(b1,qr[d0],p1,0,0,0);}
}
typedef __attribute__((address_space(3))) const char* lds_cptr;
typedef short v4i16_t __attribute__((ext_vector_type(4)));
__device__ __forceinline__ void kload8(bf16x8*kf,lds_cptr kp){
  kf[0]=*(const __attribute__((address_space(3))) bf16x8*)(kp);      kf[1]=*(const __attribute__((address_space(3))) bf16x8*)(kp+512);
  kf[2]=*(const __attribute__((address_space(3))) bf16x8*)(kp+2048); kf[3]=*(const __attribute__((address_space(3))) bf16x8*)(kp+2560);
  kf[4]=*(const __attribute__((address_space(3))) bf16x8*)(kp+4096); kf[5]=*(const __attribute__((address_space(3))) bf16x8*)(kp+4608);
  kf[6]=*(const __attribute__((address_space(3))) bf16x8*)(kp+6144); kf[7]=*(const __attribute__((address_space(3))) bf16x8*)(kp+6656);
}
__device__ __forceinline__ void kload2(bf16x8*kf,lds_cptr kp,int j){ kf[2*j]=*(const __attribute__((address_space(3))) bf16x8*)(kp+j*2048); kf[2*j+1]=*(const __attribute__((address_space(3))) bf16x8*)(kp+j*2048+512); }
__device__ __forceinline__ s16x4 vtr(lds_cptr p){ return __builtin_bit_cast(s16x4,__builtin_amdgcn_ds_read_tr16_b64_v4i16((__attribute__((address_space(3))) v4i16_t*)p)); }
__device__ __forceinline__ float rowmax(const f32x16&p0,const f32x16&p1){
  float a=max3f(p0[0],p0[1],p1[0]),b=max3f(p0[2],p0[3],p1[1]);a=max3f(a,p1[2],p1[3]);
  #pragma unroll
  for(int r=4;r<16;r+=4){a=max3f(a,p0[r],p0[r+1]);b=max3f(b,p0[r+2],p0[r+3]);a=max3f(a,p1[r],p1[r+1]);b=max3f(b,p1[r+2],p1[r+3]);}
  const float m=max2f(a,b);
  auto rr=__builtin_amdgcn_permlane32_swap(__float_as_uint(m),__float_as_uint(m),false,false);
  return max2f(__uint_as_float(rr[0]),__uint_as_float(rr[1]));
}
__device__ __forceinline__ void pv(f32x16*o,int vb,bf16x8 pa0,bf16x8 pa1,bf16x8 pa2,bf16x8 pa3){
  #pragma unroll
  for(int d0=0;d0<2;++d0){s16x4 lo[4],hi[4];
    #pragma unroll
    for(int ks=0;ks<4;++ks){
      asm volatile("ds_read_b64_tr_b16 %0,%1 offset:%c2":"=&v"(lo[ks]):"v"(vb),"i"(d0*4096+ks*1024):"memory");
      asm volatile("ds_read_b64_tr_b16 %0,%1 offset:%c2":"=&v"(hi[ks]):"v"(vb),"i"(d0*4096+ks*1024+512):"memory");}
    asm volatile("s_waitcnt lgkmcnt(0)":::"memory");SBAR();
    #define PK(k) (bf16x8){lo[k][0],lo[k][1],lo[k][2],lo[k][3],hi[k][0],hi[k][1],hi[k][2],hi[k][3]}
    o[d0]=__builtin_amdgcn_mfma_f32_32x32x16_bf16(pa0,PK(0),o[d0],0,0,0);
    o[d0]=__builtin_amdgcn_mfma_f32_32x32x16_bf16(pa1,PK(1),o[d0],0,0,0);
    o[d0]=__builtin_amdgcn_mfma_f32_32x32x16_bf16(pa2,PK(2),o[d0],0,0,0);
    o[d0]=__builtin_amdgcn_mfma_f32_32x32x16_bf16(pa3,PK(3),o[d0],0,0,0);
    #undef PK
  }
}

#ifndef ATTN_STORE16
#define ATTN_STORE16(p,v) (*(u32x4*)(p)=(v))
#endif
template<int THRL> __device__ __forceinline__ void attn_unit(int b,int h,int qb,const bf16*Q,const bf16*__restrict__ K,const bf16*__restrict__ V,bf16*O,const float*__restrict__ F2,char*shm){
  int zz_=0; asm volatile("":"+s"(zz_)); const int tid=threadIdx.x+__builtin_amdgcn_readfirstlane(zz_),lane=tid&63,r32=lane&31,hi=lane>>5; const int wid=__builtin_amdgcn_readfirstlane(tid>>6);
  const long rowbase=(long)b*SEQ; const int q0=qb*QB;
  const bf16*Qw=Q+(rowbase+q0+wid*QBLK)*DM+h*D;
  const bf16*Kh=K+rowbase*DM+h*D,*Vh=V+rowbase*DM+h*D;
  const unsigned lds0=(unsigned)(uintptr_t)shm;
  float*wsf=(float*)(shm+LDS_WS)+wid*64;
  const bf16*ksrc=Kh+(long)lane*DM+wid*8;
  const bf16*vsrc=Vh+(long)(16*(wid&3)+(lane>>2))*DM+(wid>>2)*32+(lane&3)*8;
  const unsigned kdst=lds0+LDS_K+wid*1024, vdst=lds0+LDS_V+wid*1024;
  #define DMA_K(t,slot) glds16(ksrc+(long)(t)*KVBLK*DM,(unsigned)__builtin_amdgcn_readfirstlane(kdst+(slot)))
  #define DMA_V(t,slot) glds16(vsrc+(long)(t)*KVBLK*DM,(unsigned)__builtin_amdgcn_readfirstlane(vdst+(slot)))
  const int vb0=(int)(lds0+LDS_V)+((lane>>4)&1)*32+(lane&3)*8+(4*hi+((lane&15)>>2))*64;
  const char*Kbase=shm+LDS_K; bf16x8 kf[8];
  const lds_cptr shm3=(lds_cptr)shm; const lds_cptr kp0=shm3+LDS_K+hi*1024+r32*16; const lds_cptr vp0=shm3+LDS_V+((lane>>4)&1)*32+(lane&3)*8+(4*hi+((lane&15)>>2))*64;
  const int NT=(q0+QB)/KVBLK;
  { const float*Fr=F2+(long)(b*NHEAD+h)*SEQ; const float fref=Fr[q0+QB-1]; const f32x4_t fv=*(const f32x4_t*)(Fr+4*tid);
    *(__attribute__((address_space(3))) f32x4_t*)((__attribute__((address_space(3))) char*)shm3+LDS_BIAS+16*tid)=(f32x4_t){fref-fv[0],fref-fv[1],fref-fv[2],fref-fv[3]}; }
  #define LDBIAS(P0,P1,t) do{ const lds_cptr bp_=shm3+LDS_BIAS+(t)*256+hi*16; \
    _Pragma("unroll") for(int g_=0;g_<4;++g_){ const f32x4_t x0_=*(const __attribute__((address_space(3))) f32x4_t*)(bp_+g_*32); const f32x4_t x1_=*(const __attribute__((address_space(3))) f32x4_t*)(bp_+128+g_*32); \
      P0[4*g_]=x0_[0];P0[4*g_+1]=x0_[1];P0[4*g_+2]=x0_[2];P0[4*g_+3]=x0_[3]; P1[4*g_]=x1_[0];P1[4*g_+1]=x1_[1];P1[4*g_+2]=x1_[2];P1[4*g_+3]=x1_[3]; } }while(0)
  DMA_K(0,0);DMA_V(0,0);DMA_K(1,SLOTB);
  bf16x8 qr[4];
  #pragma unroll
  for(int d0=0;d0<4;++d0)qr[d0]=*reinterpret_cast<const bf16x8*>(&Qw[(long)r32*DM+d0*16+hi*8]);
  float mhat=0.f,l_reg=0.f;f32x16 o[2];o[0]=f32x16{};o[1]=f32x16{};
  const int qrel=wid*QBLK+r32;
  #define CMASK(P0,P1,t) do{int jb_=(t)-(NT-4); if(jb_>=0)cmask(P0,P1,jb_,qrel,hi);}while(0)
  bool resc=false;
  #define START(P0,P1) do{ const float rm=rowmax(P0,P1); resc=false; \
    { const float dl=rm; mhat=fadd_s(mhat,dl); \
      _Pragma("unroll") for(int r=0;r<16;++r){P0[r]=fsub_s(P0[r],dl);P1[r]=fsub_s(P1[r],dl);} } \
    _Pragma("unroll") for(int r=0;r<16;++r)P0[r]=__builtin_amdgcn_exp2f(P0[r]); }while(0)
  #define RESC() do{ if(resc){ asm volatile("s_waitcnt lgkmcnt(0)":::"memory"); \
      _Pragma("unroll") for(int d_=0;d_<2;++d_) _Pragma("unroll") for(int r=0;r<16;++r)o[d_][r]*=wsf[crow(r,hi)]; } }while(0)
  f32x16 pA0,pA1,pB0,pB1;
  int sl_prev=0,sl_cur=0,sl_next=SLOTB;
  #define ROT() do{sl_prev=sl_cur;sl_cur=sl_next;sl_next=(sl_next==(NSLOT-1)*SLOTB)?0:sl_next+SLOTB;}while(0)
  DMA_K(2,2*SLOTB);
  WAIT_BAR(3);
  LDBIAS(pA0,pA1,0); qkt(pA0,pA1,Kbase,qr,r32,hi);asm volatile("s_nop 15\n\ts_nop 7":"+v"(pA0),"+v"(pA1));CMASK(pA0,pA1,0);
  START(pA0,pA1);
  _Pragma("unroll") for(int r=0;r<16;++r)pA1[r]=__builtin_amdgcn_exp2f(pA1[r]);
  WAIT_BAR(0);
  DMA_K(3,0);DMA_V(1,SLOTB);
  ROT();
  kload8(kf,kp0+sl_cur);
  WAIT_BAR(2);
  s16x4 vlo[8],vhi[8]; u32x4 pw0,pw1,pw2,pw3;
  #define PKW(P,B) cvtpk_s(P[B],P[B+1])
  #define PAF(k) __builtin_bit_cast(bf16x8,pw##k)
  #define VFR(i) (bf16x8){vlo[i][0],vlo[i][1],vlo[i][2],vlo[i][3],vhi[i][0],vhi[i][1],vhi[i][2],vhi[i][3]}
  #define PIN(x) asm volatile("":"+v"(x))
  #define MX3(a,b,c) __builtin_fmaxf(__builtin_fmaxf((a),(b)),(c))
  #define GAPA(MF,A0,A1,A2,A3,W0,W1,PW) do{ MF; sacc+=A0; sacc+=A1; sacc+=A2; sacc+=A3; PIN(sacc); W0; W1; PIN(PW); SBAR(); }while(0)
  #define EX(v) __builtin_amdgcn_exp2f(v)
  #define GAPB(MF,X,B) do{ MF; X[B]=EX(X[B]); X[B+1]=EX(X[B+1]); X[B+2]=EX(X[B+2]); X[B+3]=EX(X[B+3]); PIN(X); SBAR(); }while(0)
  #define VRD(i) do{ vlo[i]=vtr(vp_+(((i)>>2)*4096+((i)&3)*1024)); vhi[i]=vtr(vp_+(((i)>>2)*4096+((i)&3)*1024+512)); }while(0)
  #define KRD(G,j) do{ if(G){ kload2(kf,kp0+sl_next,j); SBAR(); } }while(0)
  #define STEP(C0,C1,P0,P1,t,GK,GV,GL) do{ SBAR(); \
    _Pragma("unroll") for(int r=0;r<16;++r){C0[r]-=mhat;C1[r]-=mhat;} \
    const lds_cptr vp_=vp0+sl_prev; \
    VRD(0); SBAR(); float sacc=(P0[0]+P0[1]); \
    GAPA(C0=__builtin_amdgcn_mfma_f32_32x32x16_bf16(kf[0],qr[0],C0,0,0,0), P0[2],P0[3],P0[4],P0[5],     pw0[0]=PKW(P0,0), pw0[1]=PKW(P0,2), pw0); \
    VRD(4); SBAR(); GAPA(C1=__builtin_amdgcn_mfma_f32_32x32x16_bf16(kf[1],qr[0],C1,0,0,0), P0[6],P0[7],P0[8],P0[9],     pw0[2]=PKW(P0,4), pw0[3]=PKW(P0,6), pw0); \
    VRD(1); SBAR(); GAPA(C0=__builtin_amdgcn_mfma_f32_32x32x16_bf16(kf[2],qr[1],C0,0,0,0),   P0[10],P0[11],P0[12],P0[13], pw1[0]=PKW(P0,8), pw1[1]=PKW(P0,10), pw1); \
    VRD(5); SBAR(); GAPA(C1=__builtin_amdgcn_mfma_f32_32x32x16_bf16(kf[3],qr[1],C1,0,0,0),   P0[14],P0[15],P1[0],P1[1],   pw1[2]=PKW(P0,12),pw1[3]=PKW(P0,14), pw1); \
    VRD(2); SBAR(); GAPA(C0=__builtin_amdgcn_mfma_f32_32x32x16_bf16(kf[4],qr[2],C0,0,0,0),   P1[2],P1[3],P1[4],P1[5],     pw2[0]=PKW(P1,0), pw2[1]=PKW(P1,2), pw2); \
    VRD(6); SBAR(); GAPA(C1=__builtin_amdgcn_mfma_f32_32x32x16_bf16(kf[5],qr[2],C1,0,0,0),   P1[6],P1[7],P1[8],P1[9],     pw2[2]=PKW(P1,4), pw2[3]=PKW(P1,6), pw2); \
    VRD(3); SBAR(); GAPA(C0=__builtin_amdgcn_mfma_f32_32x32x16_bf16(kf[6],qr[3],C0,0,0,0),   P1[10],P1[11],P1[12],P1[13], pw3[0]=PKW(P1,8), pw3[1]=PKW(P1,10), pw3); \
    VRD(7); SBAR(); GAPA(C1=__builtin_amdgcn_mfma_f32_32x32x16_bf16(kf[7],qr[3],C1,0,0,0),   P1[14],P1[15],0.f,0.f,       pw3[2]=PKW(P1,12),pw3[3]=PKW(P1,14), pw3); \
    l_reg+=sacc; if(GV){LDBIAS(P0,P1,(t)+1);} \
    if(GK){DMA_K((t)+3,sl_cur);} if(GV){DMA_V((t)+1,sl_next);} \
    CMASK(C0,C1,t); \
    { float a=MX3(C0[0],C0[1],C1[0]),b=MX3(C0[2],C0[3],C1[1]); a=MX3(a,C1[2],C1[3]); \
      _Pragma("unroll") for(int r=4;r<16;r+=4){a=MX3(a,C0[r],C0[r+1]);b=MX3(b,C0[r+2],C0[r+3]);a=MX3(a,C1[r],C1[r+1]);b=MX3(b,C1[r+2],C1[r+3]);} \
      float rm=__builtin_fmaxf(a,b); { auto rr=__builtin_amdgcn_permlane32_swap(__float_as_uint(rm),__float_as_uint(rm),false,false); rm=__builtin_fmaxf(__uint_as_float(rr[0]),__uint_as_float(rr[1])); } \
      resc=false; \
      if(__builtin_expect(__any(rm>(float)THRL),0)){ const float dl=__builtin_fmaxf(rm,0.f); mhat+=dl; \
        _Pragma("unroll") for(int r=0;r<16;++r){C0[r]-=dl;C1[r]-=dl;} \
        const float f=__builtin_amdgcn_exp2f(-dl); l_reg*=f; if(hi==0)wsf[r32]=f; resc=true; } } \
    SBAR(); \
    GAPB(o[0]=__builtin_amdgcn_mfma_f32_32x32x16_bf16(PAF(0),VFR(0),o[0],0,0,0), C0,0); \
    GAPB(o[1]=__builtin_amdgcn_mfma_f32_32x32x16_bf16(PAF(0),VFR(4),o[1],0,0,0), C0,4); \
    KRD(GL,0); GAPB(o[0]=__builtin_amdgcn_mfma_f32_32x32x16_bf16(PAF(1),VFR(1),o[0],0,0,0), C0,8); \
    KRD(GL,1); GAPB(o[1]=__builtin_amdgcn_mfma_f32_32x32x16_bf16(PAF(1),VFR(5),o[1],0,0,0), C0,12); \
    KRD(GL,2); GAPB(o[0]=__builtin_amdgcn_mfma_f32_32x32x16_bf16(PAF(2),VFR(2),o[0],0,0,0), C1,0); \
    KRD(GL,3); GAPB(o[1]=__builtin_amdgcn_mfma_f32_32x32x16_bf16(PAF(2),VFR(6),o[1],0,0,0), C1,4); \
    GAPB(o[0]=__builtin_amdgcn_mfma_f32_32x32x16_bf16(PAF(3),VFR(3),o[0],0,0,0), C1,8); \
    GAPB(o[1]=__builtin_amdgcn_mfma_f32_32x32x16_bf16(PAF(3),VFR(7),o[1],0,0,0), C1,12); \
    }while(0)
  LDBIAS(pB0,pB1,1);
  int t=1;
  #undef CMASK
  #define CMASK(P0,P1,t) do{}while(0)
  for(;t+5<NT;t+=2){
    STEP(pB0,pB1,pA0,pA1,t,true,true,true);     WAIT_BAR(2); RESC(); ROT();
    STEP(pA0,pA1,pB0,pB1,t+1,true,true,true);   WAIT_BAR(2); RESC(); ROT();
  }
  #undef CMASK
  #define CMASK(P0,P1,t) do{int jb_=(t)-(NT-4); if(jb_>=0)cmask(P0,P1,jb_,qrel,hi);}while(0)
  #define ENDW(tt) do{ if((tt)+3<NT){WAIT_BAR(2);} else if((tt)+2<NT){WAIT_BAR(1);} else {WAIT_BAR(0);} }while(0)
  for(;t+1<NT;t+=2){
    STEP(pB0,pB1,pA0,pA1,t,(t+3<NT),(t+1<NT),(t+1<NT));       ENDW(t);   RESC(); ROT();
    STEP(pA0,pA1,pB0,pB1,t+1,(t+4<NT),(t+2<NT),(t+2<NT));     ENDW(t+1); RESC(); ROT();
  }
  STEP(pB0,pB1,pA0,pA1,NT-1,false,false,false); RESC();
  { float sacc=pB0[0]+pB0[1]; _Pragma("unroll") for(int r=2;r<16;++r)sacc+=pB0[r]; _Pragma("unroll") for(int r=0;r<16;++r)sacc+=pB1[r]; l_reg+=sacc;
    pw0=(u32x4){PKW(pB0,0),PKW(pB0,2),PKW(pB0,4),PKW(pB0,6)};pw1=(u32x4){PKW(pB0,8),PKW(pB0,10),PKW(pB0,12),PKW(pB0,14)};pw2=(u32x4){PKW(pB1,0),PKW(pB1,2),PKW(pB1,4),PKW(pB1,6)};pw3=(u32x4){PKW(pB1,8),PKW(pB1,10),PKW(pB1,12),PKW(pB1,14)};
    SBAR(); pv(o,vb0+sl_cur,PAF(0),PAF(1),PAF(2),PAF(3)); }
  #undef PKW
  #undef PAF
  #undef VFR
  #undef PIN
  #undef MX3
  #undef GAPA
  #undef GAPB
  #undef EX
  #undef VRD
  #undef KRD
  #undef STEP
  #undef ENDW
  {auto rr=__builtin_amdgcn_permlane32_swap(__float_as_uint(l_reg),__float_as_uint(l_reg),false,false);l_reg=__uint_as_float(rr[0])+__uint_as_float(rr[1]);}
  if(hi==0)wsf[32+r32]=l_reg;asm volatile("s_waitcnt lgkmcnt(0)":::"memory");
  float rli[16];
  #pragma unroll
  for(int r=0;r<16;++r)rli[r]=__builtin_amdgcn_rcpf(wsf[32+crow(r,hi)]);
  bf16*Ow=O+(rowbase+q0+wid*QBLK)*DM+h*D;
  { bf16*stg=(bf16*)(shm+LDS_OST)+wid*2048;
    #pragma unroll
    for(int r=0;r<16;++r){const int orow=crow(r,hi);
      #pragma unroll
      for(int d0=0;d0<2;++d0)stg[orow*64+d0*32+r32]=__float2bfloat16(o[d0][r]*rli[r]);}
    asm volatile("s_waitcnt lgkmcnt(0)":::"memory");
    #pragma unroll
    for(int i=0;i<4;++i){const int row=i*8+(lane>>3),ch=lane&7; const u32x4 v=*(const u32x4*)(stg+row*64+ch*8); ATTN_STORE16(Ow+(long)row*DM+ch*8,v);} }
  asm volatile("s_waitcnt lgkmcnt(0)\n\ts_barrier":::"memory");
  #undef DMA_K
  #undef DMA_V
  #undef CMASK
  #undef START
  #undef RESC
  #undef ROT
  #undef LDBIAS
}
constexpr int ATTN_LDS_BYTES=LDS_BYTES;
struct AttnTensors { const bf16* Q; const bf16* K; const bf16* V; bf16* O; const float* F2; };
struct AttnUnit { int bh; int qb; };
struct StaticOrder {
  int vcu,G;
  __device__ __forceinline__ explicit StaticOrder(int grid,int v):vcu(v),G(grid){}
  __device__ __forceinline__ bool next(int i,AttnUnit&u)const{
    if(G==256){ if(i>=4)return false; const int s0=(vcu&1)*2; u.bh=vcu>>1; u.qb=(i==0)?s0:(i==1)?7-s0:(i==2)?s0+1:6-s0; return true; }
    const int L=i*G+vcu; if(L>=BATCH*NHEAD*NQB)return false; u.bh=L/NQB; u.qb=NQB-1-(L%NQB); return true; }
  __device__ __forceinline__ void a_ready(const AttnUnit&)const{}
  __device__ __forceinline__ void done(const AttnUnit&)const{}
};
template<class Sched,int THRL=8> __device__ __forceinline__ void attn_phase(char*lds,const AttnTensors&T,const Sched&S){
  AttnUnit u;
  for(int i=0;S.next(i,u);++i){ S.a_ready(u); attn_unit<THRL>(u.bh/NHEAD,u.bh%NHEAD,u.qb,T.Q,T.K,T.V,T.O,T.F2,lds); S.done(u); }
}
#undef SBAR
#undef WAIT_BAR
}
constexpr int NWAVES = 8;
constexpr int BATCH = 8, SEQ = 2048, D = 1024, FF = 4096, DEPTH = 4, NA = 2;
constexpr int M = BATCH * SEQ;
constexpr int A_PROJ = 3080, KV_PROJ = 2064;
constexpr float EPS = 1e-6f;
constexpr float LOG2E = 1.4426950408889634f;
constexpr size_t MiB = 1u << 20;
constexpr size_t WS_MOD = 1 * MiB, WS_F2 = 2 * MiB, WS_IG = 3 * MiB, WS_LF = 3 * MiB + 512 * 1024, WS_LF16 = 4 * MiB;
constexpr size_t WS_WIN = 6 * MiB, WS_WAO = 18 * MiB, WS_WKV = 22 * MiB, WS_WQ = 26 * MiB, WS_WBO = 30 * MiB, WS_W1 = 34 * MiB, WS_W2 = 66 * MiB;
constexpr size_t WS_XN = 98 * MiB, WS_KF = 130 * MiB, WS_VF = 162 * MiB, WS_OV = 194 * MiB, WS_END = 322 * MiB;
constexpr size_t WS_H = WS_OV, WS_QA = WS_OV, WS_KA = WS_OV + 16 * MiB, WS_VA = WS_OV + 32 * MiB, WS_OA = WS_OV + 64 * MiB, WS_HT = WS_OV + 96 * MiB;
constexpr size_t WS_QO = WS_OV, WS_KVN = WS_OV + 32 * MiB;
constexpr int RING_BYTES = 131072, LDS_BYTES = 147456;
constexpr int NPH = 2 + 8 * DEPTH;

#define GAS __attribute__((address_space(1)))
#define LAS __attribute__((address_space(3)))
typedef unsigned short bf16;
typedef unsigned v4u __attribute__((ext_vector_type(4)));
typedef unsigned v2u __attribute__((ext_vector_type(2)));
typedef float f32x4 __attribute__((ext_vector_type(4)));
typedef short bf16x8 __attribute__((ext_vector_type(8)));
#define LDS_WAIT() asm volatile("s_waitcnt lgkmcnt(0)" ::: "memory")
__device__ __forceinline__ unsigned f2bf(float f) { unsigned u = __builtin_bit_cast(unsigned, f); return (u + 0x7fffu + ((u >> 16) & 1u)) >> 16; }
__device__ __forceinline__ unsigned pk2(float lo, float hi) { return f2bf(lo) | (f2bf(hi) << 16); }
__device__ __forceinline__ float bflo(unsigned w) { return __uint_as_float(w << 16); }
__device__ __forceinline__ float bfhi(unsigned w) { return __uint_as_float(w & 0xffff0000u); }
__device__ __forceinline__ float bf1(unsigned short b) { return __uint_as_float((unsigned)b << 16); }
__device__ __forceinline__ float shfl_i(float v, int src_lane) { return __int_as_float(__builtin_amdgcn_ds_bpermute(src_lane << 2, __float_as_int(v))); }
__device__ __forceinline__ float wave_sum(float v, int lane) {
#pragma unroll
    for (int o = 1; o < 64; o <<= 1) v += shfl_i(v, lane ^ o);
    return v;
}
__device__ __forceinline__ float logsigmoidf_(float x) { return fminf(x, 0.f) - __logf(1.0f + __expf(-fabsf(x))); }

struct Args { const float* in[17]; float* out; unsigned char* ws; int ph_lo, ph_hi; };
enum { I_X = 0, I_C, I_ADAW, I_ADAB, I_AWIN, I_ABI, I_ABF, I_AHG, I_AWOUT, I_KVG, I_WKV, I_FGB, I_WQ, I_WBO, I_W1, I_W2, I_FG };

struct Frame {
    LAS unsigned char* lds;
    int tid, lane, wave, vcu, G, bx, z;
    const float* const* in; float* X; unsigned char* ws;
};

__device__ __forceinline__ void p0_transpose_item(const float* W, int K, int ldw, int N, bf16* WT, LAS float* scr, int item, int lane) {
    const int nblk = N / 32, kb = item / nblk, nb = item % nblk, k0 = 64 * kb, n0 = 32 * nb;
#pragma unroll 8
    for (int i = 0; i < 32; ++i) { const int kk = 2 * i + (lane >> 5); scr[kk * 33 + (lane & 31)] = W[(size_t)(k0 + kk) * ldw + n0 + (lane & 31)]; }
    LDS_WAIT(); asm volatile("" ::: "memory");
    const int c = lane & 7;
#pragma unroll
    for (int j = 0; j < 4; ++j) { const int n = (lane >> 3) + 8 * j; const LAS float* s = scr + (8 * c) * 33 + n;
        v4u o; o.x = pk2(s[0 * 33], s[1 * 33]); o.y = pk2(s[2 * 33], s[3 * 33]); o.z = pk2(s[4 * 33], s[5 * 33]); o.w = pk2(s[6 * 33], s[7 * 33]);
        *(v4u*)(WT + (size_t)(n0 + n) * K + k0 + 8 * c) = o; }
    LDS_WAIT(); asm volatile("" ::: "memory");
}
__device__ __forceinline__ void p0_prologue(Frame& F) {
    const int gw = F.vcu * NWAVES + F.wave, NGW = F.G * NWAVES;
    { const f32x4* src = (const f32x4*)F.in[I_X + F.z]; f32x4* dst = (f32x4*)F.X; const int n4 = M * D / 4;
      for (int i = F.bx * 512 + F.tid; i < n4; i += F.G * 512) dst[i] = src[i]; }
    LAS float* scr = (LAS float*)(F.lds + F.wave * 16384);
    constexpr int NITEMS = 23552;
    for (int it = gw; it < NITEMS; it += NGW) {
        int r = it; const float* src; bf16* dst; int K = 1024, ld = 1024, N = 1024;
        if (r < 3072) { const int l = r / 1536; r %= 1536; src = F.in[I_AWIN + F.z] + (size_t)l * 1024 * A_PROJ; ld = A_PROJ; N = 3072; dst = (bf16*)(F.ws + WS_WIN) + (size_t)l * 3072 * 1024; }
        else if ((r -= 3072) < 1024) { const int l = r / 512; r %= 512; src = F.in[I_AWOUT + F.z] + (size_t)l * 1024 * 1024; dst = (bf16*)(F.ws + WS_WAO) + (size_t)l * 1024 * 1024; }
        else if ((r -= 1024) < 1024) { src = F.in[I_WKV + F.z]; ld = KV_PROJ; N = 2048; dst = (bf16*)(F.ws + WS_WKV); }
        else if ((r -= 1024) < 1024) { const int l = r / 512; r %= 512; src = F.in[I_WQ + F.z] + (size_t)l * 1024 * 1024; dst = (bf16*)(F.ws + WS_WQ) + (size_t)l * 1024 * 1024; }
        else if ((r -= 1024) < 1024) { const int l = r / 512; r %= 512; src = F.in[I_WBO + F.z] + (size_t)l * 1024 * 1024; dst = (bf16*)(F.ws + WS_WBO) + (size_t)l * 1024 * 1024; }
        else if ((r -= 1024) < 8192) { const int l = r / 2048; r %= 2048; src = F.in[I_W1 + F.z] + (size_t)l * 1024 * 4096; ld = 4096; N = 4096; dst = (bf16*)(F.ws + WS_W1) + (size_t)l * 1024 * 4096; }
        else { r -= 8192; const int l = r / 2048; r %= 2048; src = F.in[I_W2 + F.z] + (size_t)l * 1024 * 4096; K = 4096; dst = (bf16*)(F.ws + WS_W2) + (size_t)l * 1024 * 4096; }
        p0_transpose_item(src, K, ld, N, dst, scr, r, F.lane);
    }
    __syncthreads();
    LAS float* cond = (LAS float*)F.lds; LAS float* red = cond + 8192;
    for (int i = F.tid; i < 8192; i += 512) { const float c = F.in[I_C + F.z][i]; cond[i] = c / (1.0f + __expf(-c)); }
    __syncthreads();
    float* MOD = (float*)(F.ws + WS_MOD);
    for (int cb = F.vcu; cb < 256; cb += F.G) {
        const int l = cb >> 6, n0 = (cb & 63) * 96;
        const float* W = F.in[I_ADAW + F.z] + (size_t)l * 1024 * 6144 + n0;
        const int c4 = F.tid % 24, ks = F.tid / 24;
        f32x4 acc[8];
#pragma unroll
        for (int b = 0; b < 8; ++b) acc[b] = (f32x4){0.f, 0.f, 0.f, 0.f};
        if (ks < 21) {
#pragma unroll 7
            for (int k = ks; k < 1024; k += 21) { const f32x4 w = *(const f32x4*)(W + (size_t)k * 6144 + c4 * 4);
#pragma unroll
                for (int b = 0; b < 8; ++b) acc[b] = acc[b] + w * cond[b * 1024 + k]; }
#pragma unroll
            for (int b = 0; b < 8; ++b) *(LAS f32x4*)(red + (ks * 8 + b) * 96 + c4 * 4) = acc[b];
        }
        __syncthreads();
        for (int o = F.tid; o < 768; o += 512) { const int b = o / 96, n = o % 96; float s = 0.f;
            for (int k2 = 0; k2 < 21; ++k2) s += red[(k2 * 8 + b) * 96 + n];
            MOD[(size_t)(l * 8 + b) * 6144 + n0 + n] = s + F.in[I_ADAB + F.z][l * 6144 + n0 + n]; }
        __syncthreads();
    }
}

__device__ __forceinline__ void load_gate_w(Frame& F, LAS float* wg, const float* W, int ld, int c0, int ng) {
    for (int idx = F.tid; idx < 1024 * ng; idx += 512) { const int k = idx / ng, g = idx % ng; wg[g * 1024 + k] = W[(size_t)k * ld + c0 + g]; }
    __syncthreads();
}
template <int MODE> __device__ __forceinline__ void norm_phase(Frame& F, int l, int which  ) {
    const int gw = F.vcu * NWAVES + F.wave, NGW = F.G * NWAVES;
    LAS float* wg = (LAS float*)F.lds;
    if (MODE == 1) load_gate_w(F, wg, F.in[I_AWIN + F.z] + (size_t)l * 1024 * A_PROJ, A_PROJ, 3072, 8);
    if (MODE == 2) load_gate_w(F, wg, F.in[I_WKV + F.z], KV_PROJ, 2048, 16);
    const float* MOD = (const float*)(F.ws + WS_MOD) + (size_t)l * 8 * 6144 + which * 3 * 1024;
    bf16* XN = (bf16*)(F.ws + WS_XN);
    for (int m = gw; m < M; m += NGW) {
        asm volatile("" ::: "memory");
        const f32x4* xr = (const f32x4*)(F.X + (size_t)m * D) + F.lane;
        f32x4 v[4]; float ss = 0.f;
#pragma unroll
        for (int j = 0; j < 4; ++j) { v[j] = xr[64 * j]; ss += (v[j].x * v[j].x + v[j].y * v[j].y) + (v[j].z * v[j].z + v[j].w * v[j].w); }
        const float r = 1.0f / sqrtf(wave_sum(ss, F.lane) * (1.0f / D) + EPS);
        const float* mb = MOD + (size_t)(m >> 11) * 6144;
        f32x4 y[4];
        v2u* o8 = (v2u*)(XN + (size_t)m * D) + F.lane;
#pragma unroll
        for (int j = 0; j < 4; ++j) { const f32x4 sh = *((const f32x4*)mb + F.lane + 64 * j), sc = *((const f32x4*)(mb + 1024) + F.lane + 64 * j);
            y[j] = v[j] * r * (sc + 1.0f) + sh; o8[64 * j] = (v2u){pk2(y[j].x, y[j].y), pk2(y[j].z, y[j].w)}; }
        if (MODE == 1) {
            float mine = 0.f;
#pragma unroll
            for (int g = 0; g < 8; ++g) { float p = 0.f;
#pragma unroll
                for (int j = 0; j < 4; ++j) { const f32x4 w = *((const LAS f32x4*)(wg + g * 1024) + F.lane + 64 * j); p += (y[j].x * w.x + y[j].y * w.y) + (y[j].z * w.z + y[j].w * w.w); }
                p = wave_sum(p, F.lane); if (F.lane == g) mine = p; asm volatile("" ::: "memory"); }
            if (F.lane < 4) ((float*)(F.ws + WS_IG))[(size_t)m * 4 + F.lane] = mine + F.in[I_ABI + F.z][l * 4 + F.lane];
            else if (F.lane < 8) ((float*)(F.ws + WS_LF))[(size_t)m * 4 + F.lane - 4] = logsigmoidf_(mine + F.in[I_ABF + F.z][l * 4 + F.lane - 4]);
        }
        if (MODE == 2) {
            v2u* k8 = (v2u*)((bf16*)(F.ws + WS_KVN) + (size_t)m * D) + F.lane;
#pragma unroll
            for (int j = 0; j < 4; ++j) { const f32x4 gn = *((const f32x4*)F.in[I_KVG + F.z] + F.lane + 64 * j); y[j] = v[j] * r * gn; k8[64 * j] = (v2u){pk2(y[j].x, y[j].y), pk2(y[j].z, y[j].w)}; }
            float mine = 0.f;
#pragma unroll
            for (int g = 0; g < 16; ++g) { float p = 0.f;
#pragma unroll
                for (int j = 0; j < 4; ++j) { const f32x4 w = *((const LAS f32x4*)(wg + g * 1024) + F.lane + 64 * j); p += (y[j].x * w.x + y[j].y * w.y) + (y[j].z * w.z + y[j].w * w.w); }
                p = wave_sum(p, F.lane); if (F.lane == g) mine = p; asm volatile("" ::: "memory"); }
            if (F.lane < 16) ((float*)(F.ws + WS_LF16))[(size_t)m * 16 + F.lane] = logsigmoidf_(mine + F.in[I_FGB + F.z][F.lane]);
        }
    }
}
__device__ __forceinline__ void fox_cumsum(Frame& F) {
    const int gw = F.vcu * NWAVES + F.wave, NGW = F.G * NWAVES;
    const float* LF16 = (const float*)(F.ws + WS_LF16); float* F2 = (float*)(F.ws + WS_F2);
    for (int bh = gw; bh < BATCH * 16; bh += NGW) {
        const int b = bh >> 4, h = bh & 15; const float* src = LF16 + ((size_t)b * SEQ + 32 * F.lane) * 16 + h;
        float tot = 0.f;
        for (int i = 0; i < 32; ++i) tot += src[i * 16];
        float inc = tot;
#pragma unroll
        for (int o = 1; o < 64; o <<= 1) { const float t = shfl_i(inc, (F.lane - o) & 63); if (F.lane >= o) inc += t; }
        float run = inc - tot; float* dst = F2 + (size_t)bh * SEQ + 32 * F.lane;
        for (int i = 0; i < 32; ++i) { run += src[i * 16]; dst[i] = run * LOG2E; }
    }
}
__device__ __forceinline__ void final_phase(Frame& F) {
    const int gw = F.vcu * NWAVES + F.wave, NGW = F.G * NWAVES;
    for (int m = gw; m < M; m += NGW) {
        f32x4* xr = (f32x4*)(F.X + (size_t)m * D) + F.lane;
        f32x4 v[4]; float ss = 0.f;
#pragma unroll
        for (int j = 0; j < 4; ++j) { v[j] = xr[64 * j]; ss += (v[j].x * v[j].x + v[j].y * v[j].y) + (v[j].z * v[j].z + v[j].w * v[j].w); }
        const float r = 1.0f / sqrtf(wave_sum(ss, F.lane) * (1.0f / D) + EPS);
#pragma unroll
        for (int j = 0; j < 4; ++j) { const f32x4 gn = *((const f32x4*)F.in[I_FG + F.z] + F.lane + 64 * j); xr[64 * j] = v[j] * r * gn; }
    }
}
__device__ __forceinline__ void mlstm_post(Frame& F, int l) {
    const int gw = F.vcu * NWAVES + F.wave, NGW = F.G * NWAVES;
    const bf16* HT = (const bf16*)(F.ws + WS_HT); const bf16* OA = (const bf16*)(F.ws + WS_OA); bf16* G = (bf16*)(F.ws + WS_XN);
    const float* hg = F.in[I_AHG + F.z] + (size_t)l * 1024;
    for (int m = gw; m < M; m += NGW) {
        const v2u* hr = (const v2u*)(HT + (size_t)m * D) + F.lane; const v2u* orow = (const v2u*)(OA + (size_t)m * D) + F.lane; v2u* gr = (v2u*)(G + (size_t)m * D) + F.lane;
#pragma unroll
        for (int j = 0; j < 4; ++j) { const v2u hv = hr[64 * j], ov = orow[64 * j];
            const float h0 = bflo(hv.x), h1 = bfhi(hv.x), h2 = bflo(hv.y), h3 = bfhi(hv.y);
            const float ss = wave_sum((h0 * h0 + h1 * h1) + (h2 * h2 + h3 * h3), F.lane);
            const float r = 1.0f / sqrtf(ss * (1.0f / 256.0f) + EPS);
            const f32x4 gn = *((const f32x4*)hg + F.lane + 64 * j);
            gr[64 * j] = (v2u){pk2(bflo(ov.x) * h0 * r * gn.x, bfhi(ov.x) * h1 * r * gn.y), pk2(bflo(ov.y) * h2 * r * gn.z, bfhi(ov.y) * h3 * r * gn.w)}; }
    }
}

__device__ __forceinline__ void mlstm_phase(Frame& F) {
    constexpr int QS = 136, TS = 72;
    LAS unsigned char* L = F.lds;
    LAS bf16* sQ = (LAS bf16*)(L); LAS bf16* sK = (LAS bf16*)(L + 17408); LAS bf16* sKT = (LAS bf16*)(L + 34816); LAS bf16* sVT = (LAS bf16*)(L + 53248);
    LAS bf16* sCT = (LAS bf16*)(L + 57856); LAS bf16* sP = (LAS bf16*)(L + 66560);
    LAS float* sN = (LAS float*)(L + 75776); LAS float* sU = sN + 128; LAS float* sM = sU + 64; LAS float* sWi = sM + 64; LAS float* sEm = sWi + 64; LAS float* sDen = sEm + 64;
    const int tid = F.tid, lane = F.lane, w = F.wave, fr = lane & 15, fq = lane >> 4;
    const bf16* QA = (const bf16*)(F.ws + WS_QA); const bf16* KA = (const bf16*)(F.ws + WS_KA); const bf16* VA = (const bf16*)(F.ws + WS_VA); bf16* HT = (bf16*)(F.ws + WS_HT);
    const float* IG = (const float*)(F.ws + WS_IG); const float* LF = (const float*)(F.ws + WS_LF);
    for (int item = F.vcu; item < 256; item += F.G) {
        const int b = item >> 5, h = (item >> 3) & 3, dvs = item & 7;
        for (int i = tid; i < 32 * QS / 2; i += 512) ((LAS unsigned*)sCT)[i] = 0u;
        if (tid < 128) sN[tid] = 0.f;
        f32x4 accC[2]; accC[0] = (f32x4){0.f, 0.f, 0.f, 0.f}; accC[1] = accC[0];
        float mst = 0.f;
        __syncthreads();
        for (int c = 0; c < SEQ / 64; ++c) {
            const size_t tok0 = (size_t)b * SEQ + (size_t)c * 64;
            const float lf = LF[(tok0 + lane) * 4 + h], ig = IG[(tok0 + lane) * 4 + h];
            float bc = lf;
#pragma unroll
            for (int o = 1; o < 64; o <<= 1) { const float t = shfl_i(bc, (lane - o) & 63); if (lane >= o) bc += t; }
            const float u = ig - bc; float cm = u;
#pragma unroll
            for (int o = 1; o < 64; o <<= 1) { const float t = shfl_i(cm, (lane - o) & 63); if (lane >= o) cm = fmaxf(cm, t); }
            const float Mt = fmaxf(mst, cm);
            const float ML = __int_as_float(__builtin_amdgcn_readlane(__float_as_int(Mt), 63)), bL = __int_as_float(__builtin_amdgcn_readlane(__float_as_int(bc), 63));
            const float wl = __expf(u - ML), decay = __expf(mst - ML);
            if (w == 0) { sU[lane] = u; sM[lane] = Mt; sWi[lane] = __expf(mst - Mt); sEm[lane] = __expf(-(bc + Mt)); }
#pragma unroll
            for (int i = 0; i < 2; ++i) { const int p = tid + 512 * i, row = p >> 4, cp = p & 15;
                const v4u qv = *(const v4u*)(QA + (tok0 + row) * 512 + h * 128 + cp * 8), kv = *(const v4u*)(KA + (tok0 + row) * 512 + h * 128 + cp * 8);
                *(LAS v4u*)(sQ + row * QS + cp * 8) = qv; *(LAS v4u*)(sK + row * QS + cp * 8) = kv;
                const float ws = shfl_i(wl, row);
                LAS bf16* kt = sKT + (cp * 8) * TS + row;
                kt[0 * TS] = (bf16)f2bf(bflo(kv.x) * ws); kt[1 * TS] = (bf16)f2bf(bfhi(kv.x) * ws); kt[2 * TS] = (bf16)f2bf(bflo(kv.y) * ws); kt[3 * TS] = (bf16)f2bf(bfhi(kv.y) * ws);
                kt[4 * TS] = (bf16)f2bf(bflo(kv.z) * ws); kt[5 * TS] = (bf16)f2bf(bfhi(kv.z) * ws); kt[6 * TS] = (bf16)f2bf(bflo(kv.w) * ws); kt[7 * TS] = (bf16)f2bf(bfhi(kv.w) * ws); }
            if (tid < 256) { const int row = tid >> 2, cp = tid & 3;
                const v4u vv = *(const v4u*)(VA + (tok0 + row) * 1024 + h * 256 + dvs * 32 + cp * 8);
                LAS bf16* vt = sVT + (cp * 8) * TS + row;
                vt[0 * TS] = (bf16)(vv.x & 0xffffu); vt[1 * TS] = (bf16)(vv.x >> 16); vt[2 * TS] = (bf16)(vv.y & 0xffffu); vt[3 * TS] = (bf16)(vv.y >> 16);
                vt[4 * TS] = (bf16)(vv.z & 0xffffu); vt[5 * TS] = (bf16)(vv.z >> 16); vt[6 * TS] = (bf16)(vv.w & 0xffffu); vt[7 * TS] = (bf16)(vv.w >> 16); }
            __syncthreads();
            { const int ti = w >> 1;
#pragma unroll
              for (int jj = 0; jj < 2; ++jj) { const int sj = 2 * (w & 1) + jj; f32x4 acc = (f32x4){0.f, 0.f, 0.f, 0.f};
#pragma unroll
                for (int ks = 0; ks < 4; ++ks) { const bf16x8 a = *(const LAS bf16x8*)(sQ + (16 * ti + fr) * QS + ks * 32 + fq * 8), bq = *(const LAS bf16x8*)(sK + (16 * sj + fr) * QS + ks * 32 + fq * 8);
                    acc = __builtin_amdgcn_mfma_f32_16x16x32_bf16(a, bq, acc, 0, 0, 0); }
                const int s = 16 * sj + fr; const float us = sU[s];
#pragma unroll
                for (int r = 0; r < 4; ++r) { const int t = 16 * ti + 4 * fq + r; const float e = __expf(fminf(us - sM[t], 0.f)); sP[t * TS + s] = (bf16)f2bf(s <= t ? acc[r] * e : 0.f); } } }
            __syncthreads();
            { const int t = tid >> 3, part = tid & 7; float rs = 0.f, qn = 0.f;
              const v4u pv = *(const LAS v4u*)(sP + t * TS + part * 8);
              rs = (bflo(pv.x) + bfhi(pv.x)) + (bflo(pv.y) + bfhi(pv.y)) + (bflo(pv.z) + bfhi(pv.z)) + (bflo(pv.w) + bfhi(pv.w));
#pragma unroll
              for (int i = 0; i < 2; ++i) { const v4u qv = *(const LAS v4u*)(sQ + t * QS + part * 16 + i * 8); const LAS float* np = sN + part * 16 + i * 8;
                  qn += bflo(qv.x) * np[0] + bfhi(qv.x) * np[1] + bflo(qv.y) * np[2] + bfhi(qv.y) * np[3] + bflo(qv.z) * np[4] + bfhi(qv.z) * np[5] + bflo(qv.w) * np[6] + bfhi(qv.w) * np[7]; }
              float den = sWi[t] * qn + rs;
              den += shfl_i(den, lane ^ 1); den += shfl_i(den, lane ^ 2); den += shfl_i(den, lane ^ 4);
              if (part == 0) sDen[t] = fmaxf(fabsf(den), sEm[t]); }
            const int ti = w >> 1, ej = w & 1;
            f32x4 acc1 = (f32x4){0.f, 0.f, 0.f, 0.f}, acc2 = acc1;
#pragma unroll
            for (int ks = 0; ks < 4; ++ks) { const bf16x8 a = *(const LAS bf16x8*)(sQ + (16 * ti + fr) * QS + ks * 32 + fq * 8), bb = *(const LAS bf16x8*)(sCT + (16 * ej + fr) * QS + ks * 32 + fq * 8);
                acc1 = __builtin_amdgcn_mfma_f32_16x16x32_bf16(a, bb, acc1, 0, 0, 0); }
#pragma unroll
            for (int ks = 0; ks < 2; ++ks) { const bf16x8 a = *(const LAS bf16x8*)(sP + (16 * ti + fr) * TS + ks * 32 + fq * 8), bb = *(const LAS bf16x8*)(sVT + (16 * ej + fr) * TS + ks * 32 + fq * 8);
                acc2 = __builtin_amdgcn_mfma_f32_16x16x32_bf16(a, bb, acc2, 0, 0, 0); }
            __syncthreads();
#pragma unroll
            for (int r = 0; r < 4; ++r) { const int t = 16 * ti + 4 * fq + r; const float hv = (sWi[t] * acc1[r] + acc2[r]) / sDen[t];
                HT[(tok0 + t) * 1024 + h * 256 + dvs * 32 + 16 * ej + fr] = (bf16)f2bf(hv); }
#pragma unroll
            for (int ei = 0; ei < 2; ++ei) { accC[ei] = accC[ei] * decay;
#pragma unroll
                for (int ks = 0; ks < 2; ++ks) { const bf16x8 a = *(const LAS bf16x8*)(sVT + (16 * ei + fr) * TS + ks * 32 + fq * 8), bb = *(const LAS bf16x8*)(sKT + (16 * w + fr) * TS + ks * 32 + fq * 8);
                    accC[ei] = __builtin_amdgcn_mfma_f32_16x16x32_bf16(a, bb, accC[ei], 0, 0, 0); }
#pragma unroll
                for (int r = 0; r < 4; ++r) sCT[(16 * ei + 4 * fq + r) * QS + 16 * w + fr] = (bf16)f2bf(accC[ei][r]); }
            { const int d = tid >> 2, part = tid & 3; float s = 0.f;
#pragma unroll
              for (int i = 0; i < 2; ++i) { const v4u kv = *(const LAS v4u*)(sKT + d * TS + part * 16 + i * 8);
                  s += (bflo(kv.x) + bfhi(kv.x)) + (bflo(kv.y) + bfhi(kv.y)) + (bflo(kv.z) + bfhi(kv.z)) + (bflo(kv.w) + bfhi(kv.w)); }
              s += shfl_i(s, lane ^ 1); s += shfl_i(s, lane ^ 2);
              if (part == 0) sN[d] = decay * sN[d] + s; }
            mst = bL + ML;
            __syncthreads();
        }
    }
}

#ifndef PHMASK
#define PHMASK 0xffff
#endif
#define PH_EN(b) (((PHMASK) >> (b)) & 1)
__global__ void __launch_bounds__(NWAVES * 64, 2) yoco_fwd(Args args) {
    extern __shared__ __attribute__((aligned(16))) unsigned char lds[];
    cg::grid_group grid = cg::this_grid();
    Frame F;
    F.lds = (LAS unsigned char*)lds;
#pragma nounroll
    for (int ph = args.ph_lo; ph < args.ph_hi; ++ph) {
        { int zz = 0; asm volatile("" : "+s"(zz)); zz = __builtin_amdgcn_readfirstlane(zz);
          const int gx = (int)gridDim.x + zz, bx = (int)blockIdx.x + zz, tx = (int)threadIdx.x + zz;
          F.X = args.out + zz; F.ws = args.ws + zz; F.in = args.in; F.z = zz; F.G = gx; F.bx = bx; F.vcu = (gx % 8 == 0) ? (bx % 8) * (gx / 8) + bx / 8 : bx;
          F.tid = tx; F.lane = tx & 63; F.wave = __builtin_amdgcn_readfirstlane(tx >> 6); }
        const float* MOD = (const float*)(F.ws + WS_MOD);
        bf16* XN = (bf16*)(F.ws + WS_XN);
        if (ph == 0) { if (PH_EN(0)) p0_prologue(F); }
        else if (ph == NPH - 1) { if (PH_EN(8)) final_phase(F); }
        else {
            const int l = (ph - 1) >> 3, sub = (ph - 1) & 7; const bool isA = l < NA;
            if (sub == 0) { if (!PH_EN(1)) continue; if (isA) norm_phase<1>(F, l, 0); else if (l == NA) norm_phase<2>(F, l, 0); else norm_phase<0>(F, l, 0); }
            else if (sub == 1) {
                if (isA) { if (!PH_EN(2)) continue;
                    pg8::Gemm g{XN, (const bf16*)(F.ws + WS_WIN) + (size_t)l * 3072 * 1024, M, 3072, D}; pg8::StaticOrder S; S.init(M, 3072, F.G, F.bx);
                    pg8::EpiStore<0> E{(bf16*)(F.ws + WS_QA), (bf16*)(F.ws + WS_KA), (bf16*)(F.ws + WS_VA), (bf16*)(F.ws + WS_OA), 0.08838834764831845f};
                    pg8::gemm_phase<pg8::EpiStore<0>, pg8::StaticOrder, true, true>(F.lds, g, S, E);
                } else { if (!PH_EN(9)) continue;
                    if (l == NA) fox_cumsum(F);
                    { pg8::Gemm g{XN, (const bf16*)(F.ws + WS_WQ) + (size_t)(l - NA) * 1024 * 1024, M, D, D}; pg8::StaticOrder S; S.init(M, D, F.G, F.bx);
                      pg8::EpiStore<1> E{(bf16*)(F.ws + WS_QO), nullptr, nullptr, nullptr, attn_body::C2};
                      pg8::gemm_phase<pg8::EpiStore<1>, pg8::StaticOrder, true, true>(F.lds, g, S, E); }
                    if (l == NA) { pg8::Gemm g{(const bf16*)(F.ws + WS_KVN), (const bf16*)(F.ws + WS_WKV), M, 2048, D}; pg8::StaticOrder S; S.init(M, 2048, F.G, F.bx);
                      pg8::EpiStore<2> E{(bf16*)(F.ws + WS_KF), (bf16*)(F.ws + WS_VF), nullptr, nullptr, 1.f};
                      pg8::gemm_phase<pg8::EpiStore<2>, pg8::StaticOrder, true, true>(F.lds, g, S, E); }
                }
            }
            else if (sub == 2) {
                if (isA) { if (PH_EN(3)) mlstm_phase(F); }
                else if (PH_EN(4)) { const attn_body::AttnTensors AT{(const attn_body::bf16*)(F.ws + WS_QO), (const attn_body::bf16*)(F.ws + WS_KF), (const attn_body::bf16*)(F.ws + WS_VF), (attn_body::bf16*)(F.ws + WS_QO), (const float*)(F.ws + WS_F2)};
                    const attn_body::StaticOrder S((int)F.G, F.vcu);
                    attn_body::attn_phase<attn_body::StaticOrder>((char*)lds, AT, S); }
            }
            else if (sub == 3) { if (isA && PH_EN(5)) mlstm_post(F, l); else continue; }
            else if (sub == 4) { if (!PH_EN(6)) continue;
                const bf16* A = isA ? (const bf16*)XN : (const bf16*)(F.ws + WS_QO);
                const bf16* Bt = isA ? (const bf16*)(F.ws + WS_WAO) + (size_t)l * 1024 * 1024 : (const bf16*)(F.ws + WS_WBO) + (size_t)(l - NA) * 1024 * 1024;
                pg8::Gemm g{A, Bt, M, D, D}; pg8::StaticOrder S; S.init(M, D, F.G, F.bx);
                pg8::EpiRes E{F.X, MOD + (size_t)l * 8 * 6144 + 2 * 1024};
                pg8::gemm_phase<pg8::EpiRes, pg8::StaticOrder, true, true>(F.lds, g, S, E);
            }
            else if (sub == 5) { if (PH_EN(1)) norm_phase<0>(F, l, 1); }
            else if (sub == 6) { if (!PH_EN(7)) continue;
                pg8::Gemm g{XN, (const bf16*)(F.ws + WS_W1) + (size_t)l * 1024 * 4096, M, FF, D}; pg8::StaticOrder S; S.init(M, FF, F.G, F.bx);
                pg8::EpiStore<3> E{(bf16*)(F.ws + WS_H), nullptr, nullptr, nullptr, 1.f};
                pg8::gemm_phase<pg8::EpiStore<3>, pg8::StaticOrder, true, true>(F.lds, g, S, E);
            }
            else { if (!PH_EN(6)) continue;
                pg8::Gemm g{(const bf16*)(F.ws + WS_H), (const bf16*)(F.ws + WS_W2) + (size_t)l * 1024 * 4096, M, D, FF}; pg8::StaticOrder S; S.init(M, D, F.G, F.bx);
                pg8::EpiRes E{F.X, MOD + (size_t)l * 8 * 6144 + 5 * 1024};
                pg8::gemm_phase<pg8::EpiRes, pg8::StaticOrder, true, true>(F.lds, g, S, E);
            }
        }
        if (ph + 1 < args.ph_hi) grid.sync();
    }
}

#ifndef MK_N_LAUNCHES
#define MK_N_LAUNCHES 1
#endif
extern "C" void kernel_launch(void* const* d_in, const int* in_sizes, int n_in, void* d_out, int out_size, void* d_ws, size_t ws_size, hipStream_t stream) {
    static int grid = 0;
    if (grid == 0) {
        if (n_in != 17 || out_size != M * D || ws_size < WS_END) { fprintf(stderr, "kernel_launch: unexpected shapes: n_in %d out %d ws %zu\n", n_in, out_size, ws_size); grid = -1; return; }
        int dev = 0, cus = 0, per_cu = 0;
        if (hipGetDevice(&dev) != hipSuccess || hipDeviceGetAttribute(&cus, hipDeviceAttributeMultiprocessorCount, dev) != hipSuccess) { grid = -1; return; }
        if (hipFuncSetAttribute((const void*)yoco_fwd, hipFuncAttributeMaxDynamicSharedMemorySize, LDS_BYTES) != hipSuccess) { fprintf(stderr, "kernel_launch: hipFuncSetAttribute failed\n"); grid = -1; return; }
        if (hipOccupancyMaxActiveBlocksPerMultiprocessor(&per_cu, (const void*)yoco_fwd, NWAVES * 64, LDS_BYTES) != hipSuccess || per_cu < 1) { fprintf(stderr, "kernel_launch: occupancy query says %d\n", per_cu); per_cu = 1; }
        (void)hipGetLastError();
        grid = cus;
    }
    if (grid < 0) return;
    Args a{};
    for (int i = 0; i < 17; ++i) a.in[i] = (const float*)d_in[i];
    a.out = (float*)d_out; a.ws = (unsigned char*)d_ws;
#if MK_N_LAUNCHES == 1
    a.ph_lo = 0; a.ph_hi = NPH;
    void* kargs[] = {&a};
    hipError_t e = hipLaunchCooperativeKernel((const void*)yoco_fwd, dim3(grid), dim3(NWAVES * 64), kargs, LDS_BYTES, stream);
    if (e != hipSuccess) fprintf(stderr, "kernel_launch: cooperative launch failed: %s (grid %d)\n", hipGetErrorString(e), grid);
#else
    for (int ph = 0; ph < NPH; ++ph) { a.ph_lo = ph; a.ph_hi = ph + 1; hipLaunchKernelGGL(yoco_fwd, dim3(grid), dim3(NWAVES * 64), LDS_BYTES, stream, a); }
#endif
}
```

```cpp
#include <hip/hip_runtime.h>
#include <cstdio>
#include <cstdint>
namespace pg8 {
#define PG8_LAS __attribute__((address_space(3)))
typedef unsigned short bf16_t;
typedef short bf16x8 __attribute__((ext_vector_type(8)));
typedef float f32x4 __attribute__((ext_vector_type(4)));
typedef unsigned u32x4 __attribute__((ext_vector_type(4)));
constexpr int BM = 256, BK = 64, HALF = 128, HTB = HALF * BK * 2  , STAGE_BYTES = 8 * HTB, NXCD = 8, WGM = 8;

__host__ __device__ __forceinline__ int lds_byte(int r, int c) { const int st = (r >> 4) * 2 + (c >> 5), rr = r & 15, cc = c & 31, ob = rr * 64 + cc * 2; return st * 1024 + (ob ^ (((ob >> 9) & 1) << 5)); }
__host__ __device__ __forceinline__ void stage_rc(int b, int& R, int& C) { const int st = b / 1024, sb = b % 1024, swz = sb ^ (((sb >> 9) & 1) << 5); R = (st >> 1) * 16 + swz / 64; C = (st & 1) * 32 + (swz % 64) / 2; }
__host__ __device__ __forceinline__ int perm32(int rho) { const int n = rho >> 4, i = rho & 15; return 8 * (i >> 2) + 4 * n + (i & 3); }

struct Unit { int pm, pn; };
struct Gemm { const bf16_t* A; const bf16_t* Bt; int M, N, K; };

struct StaticOrder {
    int nM, nN, nwg, G, c;
    __host__ __device__ void init(int M, int N, int G_, int c_) { nM = M / BM; nN = N / BM; nwg = nM * nN; G = G_; c = c_; }
    __host__ __device__ bool next(int i, Unit& u) const {
        const long L = (long)i * G + c; if (L >= nwg) return false;
        int wgid = (int)L; { const int q = nwg / NXCD, r = nwg % NXCD, xcd = wgid % NXCD, off = wgid / NXCD; wgid = (xcd < r ? xcd * (q + 1) : r * (q + 1) + (xcd - r) * q) + off; }
        const int nig = WGM * nN, gid = wgid / nig, fm = gid * WGM, gsz = (nM - fm) < WGM ? (nM - fm) : WGM;
        u.pm = fm + ((wgid % nig) % gsz); u.pn = (wgid % nig) / gsz; return true;
    }
    __device__ __forceinline__ void a_ready(const Unit&) const {}
    __device__ __forceinline__ void done(const Unit&) const {}
};

__device__ __forceinline__ unsigned cvt_pk_bf16(float lo, float hi) { unsigned r; asm volatile("v_cvt_pk_bf16_f32 %0, %1, %2" : "=v"(r) : "v"(lo), "v"(hi)); return r; }
template <int KIND> struct EpiStore {
    static constexpr bool PERM = true, AFTER_DRAIN = false, KHOOK = false;
    bf16_t *P0, *P1, *P2, *P3; const float* ss; const float* shw; float s0; int shs;
    __device__ __forceinline__ void operator()(const f32x4 (&acc)[2][2][4][2], const Unit& u, int wr, int wc, int fr, int fq) const {
        bf16_t* base = P0; int ldc = 1024, colt = u.pn * BM; float sc = 1.f; int act = 0;
        if (KIND == 0) { const int pn = u.pn;
            if (pn < 2) { base = P0; ldc = 512; colt = pn * BM; sc = s0; }
            else if (pn < 4) { base = P1; ldc = 512; colt = (pn - 2) * BM; }
            else if (pn < 8) { base = P2; ldc = 1024; colt = (pn - 4) * BM; }
            else { base = P3; ldc = 1024; colt = (pn - 8) * BM; act = 1; } }
        else if (KIND == 1) { sc = s0; }
        else if (KIND == 2) { if (u.pn >= 4) { base = P1; colt = (u.pn - 4) * BM; } }
        else { ldc = 4096; act = 2; }
        const int row0 = u.pm * BM + wr * 64 + fr, col0 = colt + wc * 32 + 8 * fq, gcol0 = u.pn * BM + wc * 32 + 8 * fq;
        f32x4 sv[2][2];
#pragma unroll
        for (int bj = 0; bj < 2; ++bj)
#pragma unroll
            for (int n = 0; n < 2; ++n) sv[bj][n] = (KIND != 2) ? *(const f32x4*)(shw + (size_t)(u.pm >> 3) * shs + gcol0 + bj * HALF + 4 * n) : (f32x4){0.f, 0.f, 0.f, 0.f};
        float rr[2][4];
#pragma unroll
        for (int ai = 0; ai < 2; ++ai)
#pragma unroll
            for (int m = 0; m < 4; ++m) rr[ai][m] = ss[row0 + ai * HALF + m * 16];
#pragma unroll
        for (int ai = 0; ai < 2; ++ai)
#pragma unroll
            for (int m = 0; m < 4; ++m) { const int row = row0 + ai * HALF + m * 16; bf16_t* rowp = base + (size_t)row * ldc + col0;
                const float r = __builtin_amdgcn_rsqf(rr[ai][m] * (1.0f / 1024.0f) + 1e-6f);
#pragma unroll
                for (int bj = 0; bj < 2; ++bj) { f32x4 v0 = acc[ai][bj][m][0] * r + sv[bj][0], v1 = acc[ai][bj][m][1] * r + sv[bj][1];
                    if (act == 1) {
#pragma unroll
                        for (int i = 0; i < 4; ++i) { v0[i] = __builtin_amdgcn_rcpf(1.0f + __expf(-v0[i])); v1[i] = __builtin_amdgcn_rcpf(1.0f + __expf(-v1[i])); } }
                    if (act == 2) {
#pragma unroll
                        for (int i = 0; i < 4; ++i) { const float a = fmaxf(v0[i], 0.f), b = fmaxf(v1[i], 0.f); v0[i] = a * a; v1[i] = b * b; } }
                    v0 = v0 * sc; v1 = v1 * sc; u32x4 w; w.x = cvt_pk_bf16(v0[0], v0[1]); w.y = cvt_pk_bf16(v0[2], v0[3]); w.z = cvt_pk_bf16(v1[0], v1[1]); w.w = cvt_pk_bf16(v1[2], v1[3]);
                    *(u32x4*)(rowp + bj * HALF) = w; } }
    }
};
struct EpiRes {
    static constexpr bool PERM = true, AFTER_DRAIN = false, KHOOK = true;
    const float* Xin; float* Xout; const float* gate; float* ssn; bf16_t* xn; const float* scn; bf16_t* kvn; const float* kvg;
    const float* hs;
    __device__ __forceinline__ void khook(f32x4 (&acc)[2][2][4][2], const Unit& u, int t, int nt, int wr, int fr) const {
        if (!hs) return;
        if (((t + 2) & 3) != 0 || t + 2 >= nt) return;
        const int hd = ((t + 2) >> 2) - 1;
        const float* hb = hs + (size_t)hd * 16384 + (u.pm * BM + wr * 64 + fr);
#pragma unroll
        for (int ai = 0; ai < 2; ++ai)
#pragma unroll
            for (int m = 0; m < 4; ++m) { const float sa = hb[ai * HALF + m * 16], sb = hb[16384 + ai * HALF + m * 16];
                const float ratio = __builtin_amdgcn_rsqf(sa * (1.0f / 256.0f) + 1e-6f) * __builtin_amdgcn_sqrtf(sb * (1.0f / 256.0f) + 1e-6f);
#pragma unroll
                for (int bj = 0; bj < 2; ++bj)
#pragma unroll
                    for (int n = 0; n < 2; ++n) acc[ai][bj][m][n] = acc[ai][bj][m][n] * ratio;
                }
    }
    __device__ __forceinline__ void operator()(const f32x4 (&acc)[2][2][4][2], const Unit& u, int wr, int wc, int fr, int fq) const {
        const size_t boff = (size_t)(u.pm >> 3) * 6144;
        const int row0 = u.pm * BM + wr * 64 + fr, col0 = u.pn * BM + wc * 32 + 8 * fq, lane = fr + 16 * fq;
        f32x4 gv[2][2], cv[2][2];
#pragma unroll
        for (int bj = 0; bj < 2; ++bj)
#pragma unroll
            for (int n = 0; n < 2; ++n) { gv[bj][n] = *(const f32x4*)(gate + boff + col0 + bj * HALF + 4 * n);
                cv[bj][n] = *(const f32x4*)(scn + boff + col0 + bj * HALF + 4 * n) + 1.0f; }
#pragma unroll
        for (int ai = 0; ai < 2; ++ai) { float sqm[4];
#pragma unroll
            for (int mh = 0; mh < 2; ++mh) {
            float r3p[2]; r3p[0] = hs ? hs[(size_t)3 * 16384 + row0 + ai * HALF + (2 * mh) * 16] : 0.f; r3p[1] = hs ? hs[(size_t)3 * 16384 + row0 + ai * HALF + (2 * mh + 1) * 16] : 0.f;
            f32x4 xp[2][2][2];
#pragma unroll
            for (int mm = 0; mm < 2; ++mm)
#pragma unroll
                for (int bj = 0; bj < 2; ++bj) { const size_t off_ = (size_t)(row0 + ai * HALF + (2 * mh + mm) * 16) * 1024 + col0 + bj * HALF; xp[mm][bj][0] = *(const f32x4*)(Xin + off_); xp[mm][bj][1] = *(const f32x4*)(Xin + off_ + 4); }
#pragma unroll
            for (int mm = 0; mm < 2; ++mm) { const int m = 2 * mh + mm; const int row = row0 + ai * HALF + m * 16; const size_t off = (size_t)row * 1024 + col0; float sq = 0.f;
                const float r3 = hs ? __builtin_amdgcn_rsqf(r3p[mm] * (1.0f / 256.0f) + 1e-6f) : 1.0f;
#pragma unroll
                for (int bj = 0; bj < 2; ++bj) { f32x4 x0 = xp[mm][bj][0], x1 = xp[mm][bj][1];
                    x0 = x0 + gv[bj][0] * (acc[ai][bj][m][0] * r3); x1 = x1 + gv[bj][1] * (acc[ai][bj][m][1] * r3);
                    *(f32x4*)(Xout + off + bj * HALF) = x0; *(f32x4*)(Xout + off + bj * HALF + 4) = x1;
                    sq += (x0[0] * x0[0] + x0[1] * x0[1]) + (x0[2] * x0[2] + x0[3] * x0[3]) + (x1[0] * x1[0] + x1[1] * x1[1]) + (x1[2] * x1[2] + x1[3] * x1[3]);
                    if (xn) { const f32x4 a0 = x0 * cv[bj][0], a1 = x1 * cv[bj][1]; u32x4 w; w.x = cvt_pk_bf16(a0[0], a0[1]); w.y = cvt_pk_bf16(a0[2], a0[3]); w.z = cvt_pk_bf16(a1[0], a1[1]); w.w = cvt_pk_bf16(a1[2], a1[3]);
                        *(u32x4*)(xn + off + bj * HALF) = w; }
                    if (kvn) { const f32x4 k0 = x0 * *(const f32x4*)(kvg + col0 + bj * HALF), k1 = x1 * *(const f32x4*)(kvg + col0 + bj * HALF + 4); u32x4 w; w.x = cvt_pk_bf16(k0[0], k0[1]); w.y = cvt_pk_bf16(k0[2], k0[3]); w.z = cvt_pk_bf16(k1[0], k1[1]); w.w = cvt_pk_bf16(k1[2], k1[3]);
                        *(u32x4*)(kvn + off + bj * HALF) = w; } }
                sq += __int_as_float(__builtin_amdgcn_ds_bpermute((lane ^ 16) << 2, __float_as_int(sq)));
                sq += __int_as_float(__builtin_amdgcn_ds_bpermute((lane ^ 32) << 2, __float_as_int(sq)));
                sqm[m] = sq;
                }
            }
            { const float mine = fq == 0 ? sqm[0] : fq == 1 ? sqm[1] : fq == 2 ? sqm[2] : sqm[3];
              (void)__hip_atomic_fetch_add(ssn + (row0 - fr) + ai * HALF + lane, mine, __ATOMIC_RELAXED, __HIP_MEMORY_SCOPE_AGENT); } }
    }
};
template <class Epi, class Sched, bool ALIGN_EPI = false, bool SP2 = false>
__device__ __forceinline__ void gemm_phase(PG8_LAS unsigned char* lds, const Gemm g, const Sched& S, const Epi& E, const int tid_in) {
    const int tid = tid_in, wid = __builtin_amdgcn_readfirstlane(tid >> 6), lane = tid & 63, wr = wid >> 2, wc = wid & 3, fr = lane & 15, fq = lane >> 4;
    const int K = g.K, nt = K / BK;
    unsigned voffA[2], voffB[2];
#pragma unroll
    for (int i = 0; i < 2; ++i) { int R, C; stage_rc(tid * 16 + i * 8192, R, C); const int Rb = Epi::PERM ? ((R & ~31) + perm32(R & 31)) : R;
        voffA[i] = (unsigned)(R * K + C) * 2u; voffB[i] = (unsigned)(Rb * K + C) * 2u; }
    const size_t kstep = (size_t)(BK * 2);
    const size_t hstep = (size_t)HALF * K * 2;
    const size_t tstep = 2 * hstep;
    const unsigned ldsw = (unsigned)wid * 1024u;
    const int aoff = lds_byte(wr * 64 + fr, fq * 8), boff = lds_byte(wc * 32 + fr, fq * 8);
#define PG8_SA(b, h) (((b) * 2 + (h)) * HTB)
#define PG8_SB(b, h) ((4 + (b) * 2 + (h)) * HTB)
#define PG8_STAGE(bufoff, gbase, voff) do { _Pragma("unroll") for (int _i = 0; _i < 2; ++_i) \
        __builtin_amdgcn_global_load_lds((const unsigned*)((const char*)(gbase) + (voff)[_i]), (PG8_LAS unsigned*)(lds + (bufoff) + ldsw + _i * 8192), 16, 0, 0); } while (0)
#define PG8_LDA(dst, b, h) do { _Pragma("unroll") for (int m = 0; m < 4; ++m) _Pragma("unroll") for (int k = 0; k < 2; ++k) dst[m][k] = *(const PG8_LAS bf16x8*)(lds + PG8_SA(b, h) + aoff + m * 2048 + k * 1024); } while (0)
#define PG8_LDB(dst, b, h) do { _Pragma("unroll") for (int n = 0; n < 2; ++n) _Pragma("unroll") for (int k = 0; k < 2; ++k) dst[n][k] = *(const PG8_LAS bf16x8*)(lds + PG8_SB(b, h) + boff + n * 2048 + k * 1024); } while (0)
#define PG8_MMA(ai, bj, At, Bt) do { __builtin_amdgcn_s_setprio(1); _Pragma("unroll") for (int m = 0; m < 4; ++m) _Pragma("unroll") for (int n = 0; n < 2; ++n) _Pragma("unroll") for (int k = 0; k < 2; ++k) \
        acc[ai][bj][m][n] = __builtin_amdgcn_mfma_f32_16x16x32_bf16(Bt[n][k], At[m][k], acc[ai][bj][m][n], 0, 0, 0); __builtin_amdgcn_s_setprio(0); } while (0)
#define PG8_WAIT_V(n) asm volatile("s_waitcnt vmcnt(" #n ")" ::: "memory")
#define PG8_WAIT_L(n) asm volatile("s_waitcnt lgkmcnt(" #n ")" ::: "memory")
#define PG8_BAR __builtin_amdgcn_s_barrier()
#define PG8_SCHED __builtin_amdgcn_sched_barrier(0)
    Unit cur, nxt; int ui = 0;
    if (!S.next(0, cur)) return;
    f32x4 acc[2][2][4][2];
#pragma unroll
    for (int a = 0; a < 2; ++a)
#pragma unroll
        for (int b = 0; b < 2; ++b)
#pragma unroll
            for (int m = 0; m < 4; ++m)
#pragma unroll
                for (int n = 0; n < 2; ++n) acc[a][b][m][n] = (f32x4){0.f, 0.f, 0.f, 0.f};
    bf16x8 At[4][2], B0[2][2], B1[2][2];
    const char* cA = (const char*)g.A + (size_t)cur.pm * tstep; const char* cB = (const char*)g.Bt + (size_t)cur.pn * tstep;
    S.a_ready(cur);
    if constexpr (SP2) {
        PG8_STAGE(PG8_SB(0, 0), cB, voffB); PG8_STAGE(PG8_SB(0, 1), cB + hstep, voffB); PG8_STAGE(PG8_SA(0, 0), cA, voffA); PG8_STAGE(PG8_SA(0, 1), cA + hstep, voffA);
        if (wr == 1) PG8_BAR;
        PG8_WAIT_V(2); PG8_BAR;
        PG8_STAGE(PG8_SB(1, 0), cB + kstep, voffB); PG8_STAGE(PG8_SA(1, 0), cA + kstep, voffA); PG8_STAGE(PG8_SB(1, 1), cB + hstep + kstep, voffB);
        PG8_WAIT_V(6); PG8_BAR;
    } else {
        PG8_STAGE(PG8_SB(0, 0), cB, voffB); PG8_STAGE(PG8_SA(0, 0), cA, voffA); PG8_STAGE(PG8_SB(0, 1), cB + hstep, voffB); PG8_STAGE(PG8_SA(0, 1), cA + hstep, voffA);
        if (wr == 1) PG8_BAR;
        PG8_WAIT_V(4); PG8_BAR;
        PG8_STAGE(PG8_SB(1, 0), cB + kstep, voffB); PG8_STAGE(PG8_SA(1, 0), cA + kstep, voffA); PG8_STAGE(PG8_SB(1, 1), cB + hstep + kstep, voffB);
        PG8_WAIT_V(6); PG8_BAR;
    }
    for (;;) {
        const bool has_next = S.next(ui + 1, nxt);
        const char* nA = has_next ? (const char*)g.A + (size_t)nxt.pm * tstep : cA; const char* nB = has_next ? (const char*)g.Bt + (size_t)nxt.pn * tstep : cB;
        for (int t = 0; t < nt; t += 2) {
            const bool last = (t == nt - 2);
            const char* a1 = cA + (size_t)(t + 1) * kstep;
            const char* a2 = last ? nA : cA + (size_t)(t + 2) * kstep; const char* b2 = last ? nB : cB + (size_t)(t + 2) * kstep;
            const char* a3 = a2 + kstep; const char* b3 = b2 + kstep;
            if (last && has_next) S.a_ready(nxt);
            if constexpr (SP2) {
            PG8_LDB(B0, 0, 0); PG8_LDB(B1, 0, 1); PG8_SCHED; PG8_LDA(At, 0, 0); PG8_STAGE(PG8_SA(1, 1), a1 + hstep, voffA);
            PG8_WAIT_V(8); PG8_WAIT_L(0); PG8_BAR; PG8_MMA(0, 0, At, B0); PG8_MMA(0, 1, At, B1); PG8_BAR; PG8_SCHED;
            PG8_LDA(At, 0, 1); PG8_STAGE(PG8_SB(0, 0), b2, voffB); PG8_STAGE(PG8_SB(0, 1), b2 + hstep, voffB); PG8_STAGE(PG8_SA(0, 0), a2, voffA);
            PG8_WAIT_V(8); PG8_WAIT_L(0); PG8_BAR; PG8_MMA(1, 0, At, B0); PG8_MMA(1, 1, At, B1); PG8_BAR; PG8_SCHED;
            PG8_LDB(B0, 1, 0); PG8_LDB(B1, 1, 1); PG8_SCHED; PG8_LDA(At, 1, 0); PG8_STAGE(PG8_SA(0, 1), a2 + hstep, voffA);
            PG8_WAIT_V(8); PG8_WAIT_L(0); PG8_BAR; PG8_MMA(0, 0, At, B0); PG8_MMA(0, 1, At, B1); PG8_BAR; PG8_SCHED;
            PG8_LDA(At, 1, 1); PG8_STAGE(PG8_SB(1, 0), b3, voffB); PG8_STAGE(PG8_SB(1, 1), b3 + hstep, voffB); PG8_STAGE(PG8_SA(1, 0), a3, voffA);
            PG8_WAIT_V(8); PG8_WAIT_L(0); PG8_BAR; PG8_MMA(1, 0, At, B0); PG8_MMA(1, 1, At, B1); PG8_BAR; PG8_SCHED;
            if constexpr (Epi::KHOOK) E.khook(acc, cur, t, nt, wr, fr);
            } else {
            PG8_LDB(B0, 0, 0); PG8_SCHED; PG8_LDA(At, 0, 0); PG8_STAGE(PG8_SA(1, 1), a1 + hstep, voffA);
            PG8_WAIT_L(8); PG8_BAR; PG8_WAIT_L(0); PG8_MMA(0, 0, At, B0); PG8_BAR; PG8_SCHED;
            PG8_LDB(B1, 0, 1); PG8_STAGE(PG8_SB(0, 0), b2, voffB);
            PG8_BAR; PG8_WAIT_L(0); PG8_MMA(0, 1, At, B1); PG8_BAR;
            PG8_LDA(At, 0, 1); PG8_STAGE(PG8_SA(0, 0), a2, voffA);
            PG8_BAR; PG8_WAIT_L(0); PG8_MMA(1, 0, At, B0); PG8_BAR; PG8_SCHED;
            PG8_STAGE(PG8_SB(0, 1), b2 + hstep, voffB);
            PG8_WAIT_V(6); PG8_BAR; PG8_MMA(1, 1, At, B1); PG8_BAR;
            PG8_LDB(B0, 1, 0); PG8_SCHED; PG8_LDA(At, 1, 0); PG8_STAGE(PG8_SA(0, 1), a2 + hstep, voffA);
            PG8_WAIT_L(8); PG8_BAR; PG8_WAIT_L(0); PG8_MMA(0, 0, At, B0); PG8_BAR; PG8_SCHED;
            PG8_LDB(B1, 1, 1); PG8_STAGE(PG8_SB(1, 0), b3, voffB);
            PG8_BAR; PG8_WAIT_L(0); PG8_MMA(0, 1, At, B1); PG8_BAR;
            PG8_LDA(At, 1, 1); PG8_STAGE(PG8_SA(1, 0), a3, voffA);
            PG8_BAR; PG8_WAIT_L(0); PG8_MMA(1, 0, At, B0); PG8_BAR; PG8_SCHED;
            PG8_STAGE(PG8_SB(1, 1), b3 + hstep, voffB);
            PG8_WAIT_V(6); PG8_BAR; PG8_MMA(1, 1, At, B1); PG8_BAR;
            }
        }
        if constexpr (ALIGN_EPI) { if (wr == 0) PG8_BAR; }
        if constexpr (!Epi::AFTER_DRAIN) { E(acc, cur, wr, wc, fr, fq); S.done(cur); }
        if (!has_next) break;
#pragma unroll
        for (int a = 0; a < 2; ++a)
#pragma unroll
            for (int b = 0; b < 2; ++b)
#pragma unroll
                for (int m = 0; m < 4; ++m)
#pragma unroll
                    for (int n = 0; n < 2; ++n) acc[a][b][m][n] = (f32x4){0.f, 0.f, 0.f, 0.f};
        cur = nxt; cA = nA; cB = nB; ++ui;
        if constexpr (ALIGN_EPI) { if (wr == 1) PG8_BAR; }
    }
    PG8_WAIT_V(0);
    if constexpr (!ALIGN_EPI) { if (wr == 0) PG8_BAR; }
    PG8_BAR;
    if constexpr (Epi::AFTER_DRAIN) { E.fused(acc, cur, wr, wc, fr, fq, lds, wid, lane); S.done(cur); }
#undef PG8_SA
#undef PG8_SB
#undef PG8_STAGE
#undef PG8_LDA
#undef PG8_LDB
#undef PG8_MMA
#undef PG8_WAIT_V
#undef PG8_WAIT_L
#undef PG8_BAR
#undef PG8_SCHED
}
}
#ifndef PG8_SP2
#define PG8_SP2 true
#endif
#include <hip/hip_bf16.h>
#include <cmath>
namespace attn_body {
using bf16=__hip_bfloat16;
using bf16x8=__attribute__((ext_vector_type(8)))short;
using s16x4=__attribute__((ext_vector_type(4)))short;
using f32x16=__attribute__((ext_vector_type(16)))float;
using u32x4=__attribute__((ext_vector_type(4)))unsigned;
using f32x4_t=__attribute__((ext_vector_type(4)))float;
constexpr int BATCH=8,NHEAD=16,SEQ=2048,D=64,DM=NHEAD*D;
constexpr int NW=8,QBLK=32,QB=QBLK*NW,KVBLK=64,NQB=SEQ/QB;
constexpr int ATTN_PITCH=DM, ATTN_UNIT_ROWS=QB;
__device__ __forceinline__ int crow(int r,int hi){return (r&3)+8*(r>>2)+4*hi;}
#define SBAR() __builtin_amdgcn_sched_barrier(0)
__device__ __forceinline__ void cmask(f32x16&p0,f32x16&p1,int jb,int qrel,int hi){
  const float NEG=-INFINITY; int kb=64*jb+4*hi;
  #pragma unroll
  for(int r=0;r<16;++r){int kv=kb+(r&3)+8*(r>>2); if(kv>qrel)p0[r]=NEG; if(kv+32>qrel)p1[r]=NEG;}
}

constexpr int NSLOT=3, SLOTB=8192;
constexpr int LDS_K=0, LDS_V=NSLOT*SLOTB, LDS_WS=2*NSLOT*SLOTB, LDS_OST=LDS_WS+NW*64*4, LDS_BIAS=LDS_OST+NW*4096, LDS_BYTES=LDS_BIAS+8192;
constexpr float C2=0.125f*1.4426950408889634f;
__device__ __forceinline__ void glds16(const void*gsrc,unsigned lds_dst){unsigned keep;
  asm volatile("s_mov_b32 %0, m0\n\ts_mov_b32 m0, %2\n\ts_nop 0\n\tglobal_load_lds_dwordx4 %1, off\n\ts_mov_b32 m0, %0":"=&s"(keep):"v"(gsrc),"s"(lds_dst):"memory");}
__device__ __forceinline__ float max3f(float a,float b,float c){float r;asm("v_max3_f32 %0, %1, %2, %3":"=v"(r):"v"(a),"v"(b),"v"(c));return r;}
__device__ __forceinline__ float max2f(float a,float b){float r;asm("v_max_f32_e32 %0, %1, %2":"=v"(r):"v"(a),"v"(b));return r;}
__device__ __forceinline__ float fadd_s(float a,float b){float r;asm("v_add_f32_e32 %0, %1, %2":"=v"(r):"v"(a),"v"(b));return r;}
__device__ __forceinline__ float fsub_s(float a,float b){float r;asm("v_sub_f32_e32 %0, %1, %2":"=v"(r):"v"(a),"v"(b));return r;}
typedef float f32x2_t __attribute__((ext_vector_type(2))); typedef __bf16 bf16x2_t __attribute__((ext_vector_type(2)));
__device__ __forceinline__ unsigned cvtpk_s(float lo,float hi){f32x2_t v={lo,hi};bf16x2_t b=__builtin_convertvector(v,bf16x2_t);return __builtin_bit_cast(unsigned,b);}
#define WAIT_BAR(N) asm volatile("s_waitcnt vmcnt(" #N ") lgkmcnt(0)\n\ts_barrier":::"memory")

__device__ __forceinline__ void qkt(f32x16&p0,f32x16&p1,const char*Kslot,const bf16x8*qr,int r32,int hi){
  const char*kb=Kslot+hi*1024+r32*16;
  #pragma unroll
  for(int d0=0;d0<4;++d0){
    const bf16x8 b0=*reinterpret_cast<const bf16x8*>(kb+d0*2048);
    const bf16x8 b1=*reinterpret_cast<const bf16x8*>(kb+d0*2048+512);
    p0=__builtin_amdgcn_mfma_f32_32x32x16_bf16(b0,qr[d0],p0,0,0,0);p1=__builtin_amdgcn_mfma_f32_32x32x16_bf16(b1,qr[d0],p1,0,0,0);}
}
typedef __attribute__((address_space(3))) const char* lds_cptr;
typedef short v4i16_t __attribute__((ext_vector_type(4)));
__device__ __forceinline__ void kload8(bf16x8*kf,lds_cptr kp){
  kf[0]=*(const __attribute__((address_space(3))) bf16x8*)(kp);      kf[1]=*(const __attribute__((address_space(3))) bf16x8*)(kp+512);
  kf[2]=*(const __attribute__((address_space(3))) bf16x8*)(kp+2048); kf[3]=*(const __attribute__((address_space(3))) bf16x8*)(kp+2560);
  kf[4]=*(const __attribute__((address_space(3))) bf16x8*)(kp+4096); kf[5]=*(const __attribute__((address_space(3))) bf16x8*)(kp+4608);
  kf[6]=*(const __attribute__((address_space(3))) bf16x8*)(kp+6144); kf[7]=*(const __attribute__((address_space(3))) bf16x8*)(kp+6656);
}
__device__ __forceinline__ void kload2(bf16x8*kf,lds_cptr kp,int j){ kf[2*j]=*(const __attribute__((address_space(3))) bf16x8*)(kp+j*2048); kf[2*j+1]=*(const __attribute__((address_space(3))) bf16x8*)(kp+j*2048+512); }
__device__ __forceinline__ s16x4 vtr(lds_cptr p){ return __builtin_bit_cast(s16x4,__builtin_amdgcn_ds_read_tr16_b64_v4i16((__attribute__((address_space(3))) v4i16_t*)p)); }
__device__ __forceinline__ float rowmax(const f32x16&p0,const f32x16&p1){
  float a=max3f(p0[0],p0[1],p1[0]),b=max3f(p0[2],p0[3],p1[1]);a=max3f(a,p1[2],p1[3]);
  #pragma unroll
  for(int r=4;r<16;r+=4){a=max3f(a,p0[r],p0[r+1]);b=max3f(b,p0[r+2],p0[r+3]);a=max3f(a,p1[r],p1[r+1]);b=max3f(b,p1[r+2],p1[r+3]);}
  const float m=max2f(a,b);
  auto rr=__builtin_amdgcn_permlane32_swap(__float_as_uint(m),__float_as_uint(m),false,false);
  return max2f(__uint_as_float(rr[0]),__uint_as_float(rr[1]));
}
__device__ __forceinline__ void pv(f32x16*o,int vb,bf16x8 pa0,bf16x8 pa1,bf16x8 pa2,bf16x8 pa3){
  #pragma unroll
  for(int d0=0;d0<2;++d0){s16x4 lo[4],hi[4];
    #pragma unroll
    for(int ks=0;ks<4;++ks){
      asm volatile("ds_read_b64_tr_b16 %0,%1 offset:%c2":"=&v"(lo[ks]):"v"(vb),"i"(d0*4096+ks*1024):"memory");
      asm volatile("ds_read_b64_tr_b16 %0,%1 offset:%c2":"=&v"(hi[ks]):"v"(vb),"i"(d0*4096+ks*1024+512):"memory");}
    asm volatile("s_waitcnt lgkmcnt(0)":::"memory");SBAR();
    #define PK(k) (bf16x8){lo[k][0],lo[k][1],lo[k][2],lo[k][3],hi[k][0],hi[k][1],hi[k][2],hi[k][3]}
    o[d0]=__builtin_amdgcn_mfma_f32_32x32x16_bf16(pa0,PK(0),o[d0],0,0,0);
    o[d0]=__builtin_amdgcn_mfma_f32_32x32x16_bf16(pa1,PK(1),o[d0],0,0,0);
    o[d0]=__builtin_amdgcn_mfma_f32_32x32x16_bf16(pa2,PK(2),o[d0],0,0,0);
    o[d0]=__builtin_amdgcn_mfma_f32_32x32x16_bf16(pa3,PK(3),o[d0],0,0,0);
    #undef PK
  }
}

#ifndef ATTN_STORE16
#define ATTN_STORE16(p,v) (*(u32x4*)(p)=(v))
#endif
template<int THRL,int VAR> __device__ __forceinline__ void attn_unit(int b,int h,int qb,const bf16*Q,const bf16*__restrict__ K,const bf16*__restrict__ V,bf16*O,const float*__restrict__ F2,bool stage_f,char*shm,const int tid_in,const bool nb){
  const int tid=tid_in,lane=tid&63,r32=lane&31,hi=lane>>5; const int wid=__builtin_amdgcn_readfirstlane(tid>>6);
  const long rowbase=(long)b*SEQ; const int q0=qb*QB;
  const bf16*Qw=Q+(rowbase+q0+wid*QBLK)*DM+h*D;
  const bf16*Kh=K+rowbase*DM+h*D,*Vh=V+rowbase*DM+h*D;
  const unsigned lds0=(unsigned)(uintptr_t)shm;
  float*wsf=(float*)(shm+LDS_WS)+wid*64;
  const bf16*ksrc=Kh+(long)lane*DM+wid*8;
  const bf16*vsrc=Vh+(long)(16*(wid&3)+(lane>>2))*DM+(wid>>2)*32+(lane&3)*8;
  const unsigned kdst=lds0+LDS_K+wid*1024, vdst=lds0+LDS_V+wid*1024;
  #define DMA_K(t,slot) glds16(ksrc+(long)(NT-1-(t))*KVBLK*DM,(unsigned)__builtin_amdgcn_readfirstlane(kdst+(slot)))
  #define DMA_V(t,slot) glds16(vsrc+(long)(NT-1-(t))*KVBLK*DM,(unsigned)__builtin_amdgcn_readfirstlane(vdst+(slot)))
  const int vb0=(int)(lds0+LDS_V)+((lane>>4)&1)*32+(lane&3)*8+(4*hi+((lane&15)>>2))*64;
  const char*Kbase=shm+LDS_K; bf16x8 kf[8];
  const lds_cptr shm3=(lds_cptr)shm; const lds_cptr kp0=shm3+LDS_K+hi*1024+r32*16; const lds_cptr vp0=shm3+LDS_V+((lane>>4)&1)*32+(lane&3)*8+(4*hi+((lane&15)>>2))*64;
  const int NT=(q0+QB)/KVBLK;
  if(stage_f){
    const float*lp=F2+((long)b*SEQ+4*tid)*16+h; float a0=lp[0],a1=lp[16],a2=lp[32],a3=lp[48]; a1+=a0;a2+=a1;a3+=a2;
    float inc=a3; int ln_=lane; asm volatile("":"+v"(ln_));
    #pragma unroll
    for(int o_=1;o_<64;o_<<=1){ const float t_=__int_as_float(__builtin_amdgcn_ds_bpermute(((ln_-o_)&63)<<2,__float_as_int(inc))); if(ln_>=o_)inc+=t_; }
    if(ln_==63)wsf[0]=inc;
    asm volatile("s_waitcnt lgkmcnt(0)\n\ts_barrier":::"memory");
    float base_=0.f; for(int w2=0;w2<wid;++w2)base_+=((const float*)(shm+LDS_WS))[w2*64];
    const float ex_=base_+inc-a3; const float L2E_=1.4426950408889634f;
    *(__attribute__((address_space(3))) f32x4_t*)((__attribute__((address_space(3))) char*)shm3+LDS_BIAS+16*tid)=(f32x4_t){(ex_+a0)*L2E_,(ex_+a1)*L2E_,(ex_+a2)*L2E_,(ex_+a3)*L2E_}; }
  #define LDBIAS(P0,P1,t) do{ if(nb){ P0=f32x16{}; P1=f32x16{}; break; } const lds_cptr bp_=shm3+LDS_BIAS+(NT-1-(t))*256+hi*16; \
    _Pragma("unroll") for(int g_=0;g_<4;++g_){ const f32x4_t x0_=*(const __attribute__((address_space(3))) f32x4_t*)(bp_+g_*32); const f32x4_t x1_=*(const __attribute__((address_space(3))) f32x4_t*)(bp_+128+g_*32); \
      P0[4*g_]=x0_[0];P0[4*g_+1]=x0_[1];P0[4*g_+2]=x0_[2];P0[4*g_+3]=x0_[3]; P1[4*g_]=x1_[0];P1[4*g_+1]=x1_[1];P1[4*g_+2]=x1_[2];P1[4*g_+3]=x1_[3]; } }while(0)
  DMA_K(0,0);DMA_V(0,0);DMA_K(1,SLOTB);
  bf16x8 qr[4];
  #pragma unroll
  for(int d0=0;d0<4;++d0)qr[d0]=*reinterpret_cast<const bf16x8*>(&Qw[(long)r32*DM+d0*16+hi*8]);
  float mhat=0.f,l_reg=0.f;f32x16 o[2];o[0]=f32x16{};o[1]=f32x16{};
  const int qrel=wid*QBLK+r32;
  #define CMASK(P0,P1,t) do{int jb_=3-(t); if(jb_>=0)cmask(P0,P1,jb_,qrel,hi);}while(0)
  bool resc=false;
  #define START(P0,P1) do{ const float rm=rowmax(P0,P1); resc=false; \
    { const float dl=(rm<-1e30f)?0.f:rm; mhat=fadd_s(mhat,dl);     \
      _Pragma("unroll") for(int r=0;r<16;++r){P0[r]=fsub_s(P0[r],dl);P1[r]=fsub_s(P1[r],dl);} } \
    _Pragma("unroll") for(int r=0;r<16;++r)P0[r]=__builtin_amdgcn_exp2f(P0[r]); }while(0)
  #define RESC() do{ if(resc){ asm volatile("s_waitcnt lgkmcnt(0)":::"memory"); \
      _Pragma("unroll") for(int d_=0;d_<2;++d_) _Pragma("unroll") for(int r=0;r<16;++r)o[d_][r]*=wsf[crow(r,hi)]; } }while(0)
  f32x16 pA0,pA1,pB0,pB1;
  int sl_prev=0,sl_cur=0,sl_next=SLOTB;
  #define ROT() do{sl_prev=sl_cur;sl_cur=sl_next;sl_next=(sl_next==(NSLOT-1)*SLOTB)?0:sl_next+SLOTB;}while(0)
  DMA_K(2,2*SLOTB);
  WAIT_BAR(3);
  const float fql=*(const __attribute__((address_space(3))) float*)(shm3+LDS_BIAS+4*(q0+wid*QBLK+r32));
  LDBIAS(pA0,pA1,0);
  _Pragma("unroll") for(int r=0;r<16;++r){pA0[r]=fql-pA0[r];pA1[r]=fql-pA1[r];}
  qkt(pA0,pA1,Kbase,qr,r32,hi);asm volatile("s_nop 15\n\ts_nop 7":"+v"(pA0),"+v"(pA1));CMASK(pA0,pA1,0);
  START(pA0,pA1);
  _Pragma("unroll") for(int r=0;r<16;++r)pA1[r]=__builtin_amdgcn_exp2f(pA1[r]);
  WAIT_BAR(0);
  DMA_K(3,0);DMA_V(1,SLOTB);
  ROT();
  kload8(kf,kp0+sl_cur);
  WAIT_BAR(2);
  s16x4 vlo[8],vhi[8]; u32x4 pw0,pw1,pw2,pw3;
  #define PKW(P,B) cvtpk_s(P[B],P[B+1])
  #define PAF(k) __builtin_bit_cast(bf16x8,pw##k)
  #define VFR(i) (bf16x8){vlo[i][0],vlo[i][1],vlo[i][2],vlo[i][3],vhi[i][0],vhi[i][1],vhi[i][2],vhi[i][3]}
  #define PIN(x) asm volatile("":"+v"(x))
  #define MX3(a,b,c) __builtin_fmaxf(__builtin_fmaxf((a),(b)),(c))
  #define GAPA(MF,MD,A0,A1,A2,A3,W0,W1,PW) do{ MF; PIN(MD); sacc+=A0; sacc+=A1; sacc+=A2; sacc+=A3; PIN(sacc); W0; W1; PIN(PW); SBAR(); }while(0)
  #define EX(v) __builtin_amdgcn_exp2f(v)
  #define GAPB(MF,X,B) do{ MF; X[B]=EX(X[B]); X[B+1]=EX(X[B+1]); X[B+2]=EX(X[B+2]); X[B+3]=EX(X[B+3]); PIN(X); SBAR(); }while(0)
  #define VRD(i) do{ vlo[i]=vtr(vp_+(((i)>>2)*4096+((i)&3)*1024)); vhi[i]=vtr(vp_+(((i)>>2)*4096+((i)&3)*1024+512)); }while(0)
  #define KRD(G,j) do{ if(G){ kload2(kf,kp0+sl_next,j); SBAR(); } }while(0)
  #define STEP(C0,C1,P0,P1,t,GK,GV,GL) do{ SBAR(); \
    const float fm_=fql-mhat; const f32x2_t fm2_={fm_,fm_}; _Pragma("unroll") for(int r=0;r<16;r+=2){ f32x2_t v_={C0[r],C0[r+1]}; v_=fm2_-v_; C0[r]=v_[0]; C0[r+1]=v_[1]; } \
    const lds_cptr vp_=vp0+sl_prev; \
    VRD(0); SBAR(); float sacc=(P0[0]+P0[1]); \
    GAPA(C0=__builtin_amdgcn_mfma_f32_32x32x16_bf16(kf[0],qr[0],C0,0,0,0),C0, P0[2],P0[3],P0[4],P0[5],     pw0[0]=PKW(P0,0), pw0[1]=PKW(P0,2), pw0); \
    _Pragma("unroll") for(int r=0;r<16;r+=2){ f32x2_t v_={C1[r],C1[r+1]}; v_=fm2_-v_; C1[r]=v_[0]; C1[r+1]=v_[1]; } PIN(C1); SBAR(); \
    VRD(4); SBAR(); GAPA(C1=__builtin_amdgcn_mfma_f32_32x32x16_bf16(kf[1],qr[0],C1,0,0,0),C1, P0[6],P0[7],P0[8],P0[9],     pw0[2]=PKW(P0,4), pw0[3]=PKW(P0,6), pw0); \
    VRD(1); SBAR(); GAPA(C0=__builtin_amdgcn_mfma_f32_32x32x16_bf16(kf[2],qr[1],C0,0,0,0),C0,   P0[10],P0[11],P0[12],P0[13], pw1[0]=PKW(P0,8), pw1[1]=PKW(P0,10), pw1); \
    VRD(5); SBAR(); GAPA(C1=__builtin_amdgcn_mfma_f32_32x32x16_bf16(kf[3],qr[1],C1,0,0,0),C1,   P0[14],P0[15],P1[0],P1[1],   pw1[2]=PKW(P0,12),pw1[3]=PKW(P0,14), pw1); \
    VRD(2); SBAR(); GAPA(C0=__builtin_amdgcn_mfma_f32_32x32x16_bf16(kf[4],qr[2],C0,0,0,0),C0,   P1[2],P1[3],P1[4],P1[5],     pw2[0]=PKW(P1,0), pw2[1]=PKW(P1,2), pw2); \
    VRD(6); SBAR(); GAPA(C1=__builtin_amdgcn_mfma_f32_32x32x16_bf16(kf[5],qr[2],C1,0,0,0),C1,   P1[6],P1[7],P1[8],P1[9],     pw2[2]=PKW(P1,4), pw2[3]=PKW(P1,6), pw2); \
    VRD(3); SBAR(); GAPA(C0=__builtin_amdgcn_mfma_f32_32x32x16_bf16(kf[6],qr[3],C0,0,0,0),C0,   P1[10],P1[11],P1[12],P1[13], pw3[0]=PKW(P1,8), pw3[1]=PKW(P1,10), pw3); \
    VRD(7); SBAR(); GAPA(C1=__builtin_amdgcn_mfma_f32_32x32x16_bf16(kf[7],qr[3],C1,0,0,0),C1,   P1[14],P1[15],0.f,0.f,       pw3[2]=PKW(P1,12),pw3[3]=PKW(P1,14), pw3); \
    l_reg+=sacc; if(GV){LDBIAS(P0,P1,(t)+1);} \
    if(GK){DMA_K((t)+3,sl_cur);} if(GV){DMA_V((t)+1,sl_next);} \
    CMASK(C0,C1,t); \
    { float a=MX3(C0[0],C0[1],C1[0]),b=MX3(C0[2],C0[3],C1[1]); a=MX3(a,C1[2],C1[3]); \
      _Pragma("unroll") for(int r=4;r<16;r+=4){a=MX3(a,C0[r],C0[r+1]);b=MX3(b,C0[r+2],C0[r+3]);a=MX3(a,C1[r],C1[r+1]);b=MX3(b,C1[r+2],C1[r+3]);} \
      float rm=__builtin_fmaxf(a,b); { auto rr=__builtin_amdgcn_permlane32_swap(__float_as_uint(rm),__float_as_uint(rm),false,false); rm=__builtin_fmaxf(__uint_as_float(rr[0]),__uint_as_float(rr[1])); } \
      resc=false; \
      if(__builtin_expect(__any(rm>(float)THRL),0)){ const float dl=__builtin_fmaxf(rm,0.f); mhat+=dl; \
        _Pragma("unroll") for(int r=0;r<16;++r){C0[r]-=dl;C1[r]-=dl;} \
        const float f=__builtin_amdgcn_exp2f(-dl); l_reg*=f; if(hi==0)wsf[r32]=f; resc=true; } } \
    SBAR(); \
    GAPB(o[0]=__builtin_amdgcn_mfma_f32_32x32x16_bf16(PAF(0),VFR(0),o[0],0,0,0), C0,0); \
    GAPB(o[1]=__builtin_amdgcn_mfma_f32_32x32x16_bf16(PAF(0),VFR(4),o[1],0,0,0), C0,4); \
    KRD(GL,0); GAPB(o[0]=__builtin_amdgcn_mfma_f32_32x32x16_bf16(PAF(1),VFR(1),o[0],0,0,0), C0,8); \
    KRD(GL,1); GAPB(o[1]=__builtin_amdgcn_mfma_f32_32x32x16_bf16(PAF(1),VFR(5),o[1],0,0,0), C0,12); \
    KRD(GL,2); GAPB(o[0]=__builtin_amdgcn_mfma_f32_32x32x16_bf16(PAF(2),VFR(2),o[0],0,0,0), C1,0); \
    KRD(GL,3); GAPB(o[1]=__builtin_amdgcn_mfma_f32_32x32x16_bf16(PAF(2),VFR(6),o[1],0,0,0), C1,4); \
    GAPB(o[0]=__builtin_amdgcn_mfma_f32_32x32x16_bf16(PAF(3),VFR(3),o[0],0,0,0), C1,8); \
    GAPB(o[1]=__builtin_amdgcn_mfma_f32_32x32x16_bf16(PAF(3),VFR(7),o[1],0,0,0), C1,12); \
    }while(0)
  LDBIAS(pB0,pB1,1);
  int t=1;
  #define ENDW(tt) do{ if((tt)+3<NT){WAIT_BAR(2);} else if((tt)+2<NT){WAIT_BAR(1);} else {WAIT_BAR(0);} }while(0)
  for(;t<5&&t+1<NT;t+=2){
    STEP(pB0,pB1,pA0,pA1,t,(t+3<NT),(t+1<NT),(t+1<NT));       ENDW(t);   RESC(); ROT();
    STEP(pA0,pA1,pB0,pB1,t+1,(t+4<NT),(t+2<NT),(t+2<NT));     ENDW(t+1); RESC(); ROT();
  }
  #undef CMASK
  #define CMASK(P0,P1,t) do{}while(0)
  for(;t+5<NT;t+=2){
    STEP(pB0,pB1,pA0,pA1,t,true,true,true);     WAIT_BAR(2); RESC(); ROT();
    STEP(pA0,pA1,pB0,pB1,t+1,true,true,true);   WAIT_BAR(2); RESC(); ROT();
  }
  for(;t+1<NT;t+=2){
    STEP(pB0,pB1,pA0,pA1,t,(t+3<NT),(t+1<NT),(t+1<NT));       ENDW(t);   RESC(); ROT();
    STEP(pA0,pA1,pB0,pB1,t+1,(t+4<NT),(t+2<NT),(t+2<NT));     ENDW(t+1); RESC(); ROT();
  }
  #undef CMASK
  #define CMASK(P0,P1,t) do{int jb_=3-(t); if(jb_>=0)cmask(P0,P1,jb_,qrel,hi);}while(0)
  STEP(pB0,pB1,pA0,pA1,NT-1,false,false,false); RESC();
  { float sacc=pB0[0]+pB0[1]; _Pragma("unroll") for(int r=2;r<16;++r)sacc+=pB0[r]; _Pragma("unroll") for(int r=0;r<16;++r)sacc+=pB1[r]; l_reg+=sacc;
    pw0=(u32x4){PKW(pB0,0),PKW(pB0,2),PKW(pB0,4),PKW(pB0,6)};pw1=(u32x4){PKW(pB0,8),PKW(pB0,10),PKW(pB0,12),PKW(pB0,14)};pw2=(u32x4){PKW(pB1,0),PKW(pB1,2),PKW(pB1,4),PKW(pB1,6)};pw3=(u32x4){PKW(pB1,8),PKW(pB1,10),PKW(pB1,12),PKW(pB1,14)};
    SBAR(); pv(o,vb0+sl_cur,PAF(0),PAF(1),PAF(2),PAF(3)); }
  #undef PKW
  #undef PAF
  #undef VFR
  #undef PIN
  #undef MX3
  #undef GAPA
  #undef GAPB
  #undef EX
  #undef VRD
  #undef KRD
  #undef STEP
  #undef ENDW
  {auto rr=__builtin_amdgcn_permlane32_swap(__float_as_uint(l_reg),__float_as_uint(l_reg),false,false);l_reg=__uint_as_float(rr[0])+__uint_as_float(rr[1]);}
  if(hi==0)wsf[32+r32]=l_reg;asm volatile("s_waitcnt lgkmcnt(0)":::"memory");
  float rli[16];
  #pragma unroll
  for(int r=0;r<16;++r)rli[r]=__builtin_amdgcn_rcpf(wsf[32+crow(r,hi)]);
  bf16*Ow=O+(rowbase+q0+wid*QBLK)*DM+h*D;
  { bf16*stg=(bf16*)(shm+LDS_OST)+wid*2048;
    #pragma unroll
    for(int r=0;r<16;++r){const int orow=crow(r,hi);
      #pragma unroll
      for(int d0=0;d0<2;++d0)stg[orow*64+d0*32+r32]=__float2bfloat16(o[d0][r]*rli[r]);}
    asm volatile("s_waitcnt lgkmcnt(0)":::"memory");
    #pragma unroll
    for(int i=0;i<4;++i){const int row=i*8+(lane>>3),ch=lane&7; const u32x4 v=*(const u32x4*)(stg+row*64+ch*8); ATTN_STORE16(Ow+(long)row*DM+ch*8,v);} }
  asm volatile("s_waitcnt lgkmcnt(0)\n\ts_barrier":::"memory");
  #undef DMA_K
  #undef DMA_V
  #undef CMASK
  #undef START
  #undef RESC
  #undef ROT
  #undef LDBIAS
}
constexpr int ATTN_LDS_BYTES=LDS_BYTES;
struct AttnTensors { const bf16* Q; const bf16* K; const bf16* V; bf16* O; const float* F2; };
struct AttnUnit { int bh; int qb; };
struct StaticOrder {
  int vcu,G,fqb;
  __device__ __forceinline__ explicit StaticOrder(int grid,int v,int f=-1):vcu(v),G(grid),fqb(f){}
  __device__ __forceinline__ bool next(int i,AttnUnit&u)const{
    if(G==256){ if(i>=4)return false; const int s=vcu&3; u.bh=(i>>1)*64+(vcu>>2); u.qb=(i&1)?7-s:s; if(fqb>=0)u.qb=fqb; return true; }
    const int L=i*G+vcu; if(L>=BATCH*NHEAD*NQB)return false; u.bh=L/NQB; u.qb=NQB-1-(L%NQB); return true; }
  __device__ __forceinline__ void a_ready(const AttnUnit&)const{}
  __device__ __forceinline__ void done(const AttnUnit&)const{}
};
template<class Sched,int VAR=0,int THRL=8> __device__ __forceinline__ void attn_phase(char*lds,const AttnTensors&T,const Sched&S,const int tid_in,const bool nb=false){
  AttnUnit u; int last_bh=-1;
  for(int i=0;S.next(i,u);++i){ S.a_ready(u); attn_unit<THRL,VAR>(u.bh/NHEAD,u.bh%NHEAD,u.qb,T.Q,T.K,T.V,T.O,T.F2,u.bh!=last_bh,lds,tid_in,nb); last_bh=u.bh; S.done(u); }
}
#undef SBAR
#undef WAIT_BAR
}
constexpr int NWAVES = 8;
constexpr int BATCH = 8, SEQ = 2048, D = 1024, FF = 4096, DEPTH = 4, NA = 2;
constexpr int M = BATCH * SEQ;
constexpr int A_PROJ = 3080, KV_PROJ = 2064;
constexpr float EPS = 1e-6f;
constexpr float LOG2E = 1.4426950408889634f;
constexpr size_t MiB = 1u << 20;
constexpr size_t WS_BAR = 0, WS_BAR_BYTES = 16384;
constexpr size_t WS_MOD = 1 * MiB, WS_F2 = 2 * MiB, WS_IG = 3 * MiB, WS_LF = 3 * MiB + 512 * 1024, WS_LF16 = 4 * MiB;
constexpr size_t WS_WIN = 6 * MiB, WS_WAO = 18 * MiB, WS_WKV = 22 * MiB, WS_WQ = 26 * MiB, WS_WBO = 30 * MiB, WS_W1 = 34 * MiB, WS_W2 = 66 * MiB;
constexpr size_t WS_XN = 98 * MiB, WS_KF = 130 * MiB, WS_VF = 162 * MiB, WS_OV = 194 * MiB, WS_KVN = 322 * MiB, WS_SS = 354 * MiB, WS_SHW = 355 * MiB, WS_HS = 356 * MiB, WS_END = 357 * MiB;
constexpr size_t WS_PTR = 5 * MiB + 512 * 1024;
constexpr size_t WS_PAR = 5 * MiB;
constexpr int PG_IN = 0, PG_KV = 16384, PBI = 32768, PBF = 32776, PHG = 32784, PKVG = 34832, PFGB = 35856, PFG = 35872, PAR_N = 36896;
constexpr size_t WS_H = WS_OV, WS_QA = WS_OV, WS_KA = WS_OV + 16 * MiB, WS_VA = WS_OV + 32 * MiB, WS_OA = WS_OV + 64 * MiB, WS_HT = WS_OV + 96 * MiB;
constexpr size_t WS_QO = WS_OV, WS_G = WS_OV;
constexpr int SHW_IN = 0, SHW_UP = 2 * 8 * A_PROJ, SHW_Q = SHW_UP + 4 * 8 * 4096;
constexpr int RING_BYTES = 131072, LDS_BYTES = 147456, MISC_OFF = LDS_BYTES - 256;
constexpr int NPH = 3 + 6 * DEPTH;

#define GAS __attribute__((address_space(1)))
#define LAS __attribute__((address_space(3)))
typedef unsigned short bf16;
typedef unsigned v4u __attribute__((ext_vector_type(4)));
typedef unsigned v2u __attribute__((ext_vector_type(2)));
typedef float f32x4 __attribute__((ext_vector_type(4)));
typedef short bf16x8 __attribute__((ext_vector_type(8)));
#define LDS_WAIT() asm volatile("s_waitcnt lgkmcnt(0)" ::: "memory")
typedef float f32x2h_t __attribute__((ext_vector_type(2))); typedef __bf16 bf16x2h_t __attribute__((ext_vector_type(2)));
__device__ __forceinline__ unsigned pk2(float lo, float hi) { const f32x2h_t v = {lo, hi}; return __builtin_bit_cast(unsigned, __builtin_convertvector(v, bf16x2h_t)); }
__device__ __forceinline__ unsigned f2bf(float f) { return pk2(f, 0.f) & 0xffffu; }
__device__ __forceinline__ float bflo(unsigned w) { return __uint_as_float(w << 16); }
__device__ __forceinline__ float bfhi(unsigned w) { return __uint_as_float(w & 0xffff0000u); }
__device__ __forceinline__ float bf1(unsigned short b) { return __uint_as_float((unsigned)b << 16); }
__device__ __forceinline__ float shfl_i(float v, int src_lane) { return __int_as_float(__builtin_amdgcn_ds_bpermute(src_lane << 2, __float_as_int(v))); }
__device__ __forceinline__ float wave_sum(float v, int lane) {
#pragma unroll
    for (int o = 1; o < 64; o <<= 1) v += shfl_i(v, lane ^ o);
    return v;
}
__device__ __forceinline__ float logsigmoidf_(float x) { return fminf(x, 0.f) - __logf(1.0f + __expf(-fabsf(x))); }

#define RLX_AGENT __ATOMIC_RELAXED, __HIP_MEMORY_SCOPE_AGENT
#define XB_TMO      128
#define XB_XCNT(j)  (256  + 64 * (j))
#define XB_XSUB(j)  (1280 + 64 * (j))
#define XB_XGEN(j)  (2304 + 64 * (j))
#define XB_TOP      3328
#define XB_TOPGEN   3392
#define XCD_BAR_WORDS 3456
#define XB_SPIN_CAP (1u << 18)

__device__ __forceinline__ unsigned xb_ld(unsigned* p)              { return __hip_atomic_load(p, __ATOMIC_RELAXED, __HIP_MEMORY_SCOPE_AGENT); }
__device__ __forceinline__ unsigned xb_add(unsigned* p, unsigned v) { return __hip_atomic_fetch_add(p, v, __ATOMIC_RELAXED, __HIP_MEMORY_SCOPE_AGENT); }
__device__ __forceinline__ unsigned xb_xcc_id() { return (unsigned)__builtin_amdgcn_s_getreg((3 << 11) | 20) & 0xFu; }
#define XB_SPIN(cond, bar) do { unsigned _sp = 0; while (cond) { __builtin_amdgcn_s_sleep(1); \
    if ((++_sp & 255u) == 0u) { if (xb_ld(&(bar)[XB_TMO])) break; if (_sp > XB_SPIN_CAP) { atomicAdd(&(bar)[XB_TMO], 1u); break; } } } } while (0)

struct XcdBarrier {
    unsigned* bar; unsigned x;
    volatile LAS unsigned* st;
};

__device__ __forceinline__ XcdBarrier xcd_barrier_post(unsigned* bar, volatile LAS unsigned* st, int tid_) {
    XcdBarrier b; b.bar = bar; b.x = xb_xcc_id(); b.st = st;
    if (tid_ == 0) (void)xb_add(&bar[XB_XCNT(b.x)], 1u);
    return b;
}
__device__ __forceinline__ void xcd_barrier_complete(unsigned* bar, unsigned x, unsigned& nloc, unsigned& nx) {
    const unsigned G = gridDim.x * gridDim.y * gridDim.z;
    unsigned sum, cnt, mine, sp = 0u;
    for (;;) {
        sum = 0u; cnt = 0u; mine = 0u;
#pragma unroll
        for (unsigned j = 0; j < 16; ++j) { const unsigned c = xb_ld(&bar[XB_XCNT(j)]); sum += c; cnt += (c > 0u) ? 1u : 0u; mine = (j == x) ? c : mine; }
        if (sum == G) break;
        __builtin_amdgcn_s_sleep(1);
        if ((++sp & 255u) == 0u) { if (xb_ld(&bar[XB_TMO])) break; if (sp > XB_SPIN_CAP) { atomicAdd(&bar[XB_TMO], 1u); break; } }
    }
    nloc = mine > 0u ? mine : 1u; nx = cnt > 0u ? cnt : 1u;
}

__device__ __forceinline__ void xcd_barrier(const XcdBarrier& b, int tid_) {
    asm volatile("s_waitcnt vmcnt(0)" ::: "memory");
    __syncthreads();
    if (tid_ == 0) {
        unsigned* bar = b.bar;
        __builtin_amdgcn_s_waitcnt(0);
        unsigned nloc = b.st[0], nx = b.st[1];
        if (nloc == 0u) { xcd_barrier_complete(bar, b.x, nloc, nx); b.st[0] = nloc; b.st[1] = nx; }
        const unsigned old = xb_add(&bar[XB_XSUB(b.x)], 1u);
        const unsigned gen = old / nloc;
        if (old + 1u == (gen + 1u) * nloc) {
            __builtin_amdgcn_fence(__ATOMIC_RELEASE, "agent");
            asm volatile("s_waitcnt vmcnt(0)" ::: "memory");
            const unsigned og = xb_add(&bar[XB_TOP], 1u);
            const unsigned tg = og / nx;
            if (og + 1u == (tg + 1u) * nx) xb_add(&bar[XB_TOPGEN], 1u);
            else XB_SPIN(xb_ld(&bar[XB_TOPGEN]) == tg, bar);
            __builtin_amdgcn_fence(__ATOMIC_ACQUIRE, "agent");
            xb_add(&bar[XB_XGEN(b.x)], 1u);
            asm volatile("s_waitcnt vmcnt(0)" ::: "memory");
        } else {
            XB_SPIN(xb_ld(&bar[XB_XGEN(b.x)]) == gen, bar);
            __builtin_amdgcn_fence(__ATOMIC_ACQUIRE, "agent");
            asm volatile("s_waitcnt vmcnt(0)" ::: "memory");
        }
    }
    __syncthreads();
}

struct Args { const float* in[17]; float* out; unsigned char* ws; int ph_lo, ph_hi; };
enum { I_X = 0, I_C, I_ADAW, I_ADAB, I_AWIN, I_ABI, I_ABF, I_AHG, I_AWOUT, I_KVG, I_WKV, I_FGB, I_WQ, I_WBO, I_W1, I_W2, I_FG };

struct Frame {
    LAS unsigned char* lds;
    int tid, lane, wave, vcu, G, bx;
    float* X; unsigned char* ws;
};

__device__ __forceinline__ void p0_transpose_item(const float* W, int K, int ldw, int N, bf16* WT, LAS float* scr, int item, int lane) {
    const int nblk = N / 32, kb = item / nblk, nb = item % nblk, k0 = 64 * kb, n0 = 32 * nb;
    { f32x4 v[8];
#pragma unroll
      for (int i = 0; i < 8; ++i) v[i] = *(const f32x4*)(W + (size_t)(k0 + (lane >> 3) + 8 * i) * ldw + n0 + (lane & 7) * 4);
#pragma unroll
      for (int i = 0; i < 8; ++i) { LAS float* d = scr + ((lane >> 3) + 8 * i) * 33 + (lane & 7) * 4; d[0] = v[i].x; d[1] = v[i].y; d[2] = v[i].z; d[3] = v[i].w; } }
    LDS_WAIT(); asm volatile("" ::: "memory");
    const int c = lane & 7;
#pragma unroll
    for (int j = 0; j < 4; ++j) { const int n = (lane >> 3) + 8 * j; const LAS float* s = scr + (8 * c) * 33 + n;
        v4u o; o.x = pk2(s[0 * 33], s[1 * 33]); o.y = pk2(s[2 * 33], s[3 * 33]); o.z = pk2(s[4 * 33], s[5 * 33]); o.w = pk2(s[6 * 33], s[7 * 33]);
        *(v4u*)(WT + (size_t)(n0 + n) * K + k0 + 8 * c) = o; }
    LDS_WAIT(); asm volatile("" ::: "memory");
}
__device__ __forceinline__ void gemv8_item(Frame& F, const float* vec, int vs, bool silu, const float* W, int ld, int ncols, float* out, int os, const float* bias, const bool nt = false) {
    LAS float* cond = (LAS float*)F.lds; LAS float* red = cond + 8192;
    for (int i = F.tid; i < 8192; i += 512) { const float c = vec[(size_t)(i >> 10) * vs + (i & 1023)]; cond[i] = silu ? c / (1.0f + __expf(-c)) : c; }
    __syncthreads();
    const int c4 = F.tid & 31, ks = F.tid >> 5;
    if (c4 * 4 < ncols) {
        f32x4 acc[8];
#pragma unroll
        for (int b = 0; b < 8; ++b) acc[b] = (f32x4){0.f, 0.f, 0.f, 0.f};
#pragma unroll 16
        for (int k = ks; k < 1024; k += 16) { const f32x4* wp = (const f32x4*)(W + (size_t)k * ld + c4 * 4); const f32x4 w = nt ? __builtin_nontemporal_load(wp) : *wp;
#pragma unroll
            for (int b = 0; b < 8; ++b) acc[b] = acc[b] + w * cond[b * 1024 + k]; }
#pragma unroll
        for (int b = 0; b < 8; ++b) *(LAS f32x4*)(red + (ks * 8 + b) * 128 + c4 * 4) = acc[b];
    }
    __syncthreads();
    for (int o = F.tid; o < 1024; o += 512) { const int b = o >> 7, n = o & 127;
        if (n < ncols) { float s = 0.f;
#pragma unroll
            for (int k2 = 0; k2 < 16; ++k2) s += red[(k2 * 8 + b) * 128 + n];
            out[(size_t)b * os + n] = s + (bias ? bias[n] : 0.f); } }
    __syncthreads();
}
__device__ __forceinline__ void p0_prologue(Frame& F, const Args& args) {
    const int gw = F.vcu * NWAVES + F.wave, NGW = F.G * NWAVES;
    { f32x4* z = (f32x4*)(F.ws + WS_SS) + M / 4; for (int i = F.bx * 512 + F.tid; i < 8 * M / 4; i += F.G * 512) z[i] = (f32x4){0.f, 0.f, 0.f, 0.f};
      f32x4* zh = (f32x4*)(F.ws + WS_HS); for (int i = F.bx * 512 + F.tid; i < 2 * M; i += F.G * 512) zh[i] = (f32x4){0.f, 0.f, 0.f, 0.f}; }
    { float* P = (float*)(F.ws + WS_PAR);
      for (int i = F.bx * 512 + F.tid; i < PAR_N; i += F.G * 512) { float v;
          if (i < PG_KV) { const int l = i >> 13, g = (i >> 10) & 7, k = i & 1023; v = args.in[I_AWIN][(size_t)l * 1024 * A_PROJ + (size_t)k * A_PROJ + 3072 + g]; }
          else if (i < PBI) { const int g = (i - PG_KV) >> 10, k = i & 1023; v = args.in[I_WKV][(size_t)k * KV_PROJ + 2048 + g]; }
          else if (i < PBF) v = args.in[I_ABI][i - PBI];
          else if (i < PHG) v = args.in[I_ABF][i - PBF];
          else if (i < PKVG) v = args.in[I_AHG][i - PHG];
          else if (i < PFGB) v = args.in[I_KVG][i - PKVG];
          else if (i < PFG) v = args.in[I_FGB][i - PFGB];
          else v = args.in[I_FG][i - PFG];
          P[i] = v; } }
#ifndef REP_ADA
#define REP_ADA 1
#endif
    for (int rp_ = 0; rp_ < REP_ADA; ++rp_)
    for (int it = F.vcu; it < 256; it += F.G) { const int l = it >> 6, n0 = (it & 63) * 96;
        gemv8_item(F, args.in[I_C], 1024, true, args.in[I_ADAW] + (size_t)l * 1024 * 6144 + n0, 6144, 96, (float*)(F.ws + WS_MOD) + (size_t)l * 8 * 6144 + n0, 6144, args.in[I_ADAB] + l * 6144 + n0, true); }
    LAS float* scr = (LAS float*)(F.lds + F.wave * 16384);
    constexpr int NITEMS = 23552;
#ifndef REP_TR
#define REP_TR 1
#endif
    for (int rp_ = 0; rp_ < REP_TR; ++rp_)
    for (int it = gw; it < NITEMS; it += NGW) {
        int r = it; const float* src; bf16* dst; int K = 1024, ld = 1024, N = 1024;
        if (r < 3072) { const int l = r / 1536; r %= 1536; src = args.in[I_AWIN] + (size_t)l * 1024 * A_PROJ; ld = A_PROJ; N = 3072; dst = (bf16*)(F.ws + WS_WIN) + (size_t)l * 3072 * 1024; }
        else if ((r -= 3072) < 1024) { const int l = r / 512; r %= 512; src = args.in[I_AWOUT] + (size_t)l * 1024 * 1024; dst = (bf16*)(F.ws + WS_WAO) + (size_t)l * 1024 * 1024; }
        else if ((r -= 1024) < 1024) { src = args.in[I_WKV]; ld = KV_PROJ; N = 2048; dst = (bf16*)(F.ws + WS_WKV); }
        else if ((r -= 1024) < 1024) { const int l = r / 512; r %= 512; src = args.in[I_WQ] + (size_t)l * 1024 * 1024; dst = (bf16*)(F.ws + WS_WQ) + (size_t)l * 1024 * 1024; }
        else if ((r -= 1024) < 1024) { const int l = r / 512; r %= 512; src = args.in[I_WBO] + (size_t)l * 1024 * 1024; dst = (bf16*)(F.ws + WS_WBO) + (size_t)l * 1024 * 1024; }
        else if ((r -= 1024) < 8192) { const int l = r / 2048; r %= 2048; src = args.in[I_W1] + (size_t)l * 1024 * 4096; ld = 4096; N = 4096; dst = (bf16*)(F.ws + WS_W1) + (size_t)l * 1024 * 4096; }
        else { r -= 8192; const int l = r / 2048; r %= 2048; src = args.in[I_W2] + (size_t)l * 1024 * 4096; K = 4096; dst = (bf16*)(F.ws + WS_W2) + (size_t)l * 1024 * 4096; }
        p0_transpose_item(src, K, ld, N, dst, scr, r, F.lane);
    }
}
__device__ __forceinline__ void p1_prologue(Frame& F, const Args& args) {
    const int gw = F.vcu * NWAVES + F.wave, NGW = F.G * NWAVES;
    const float* MOD = (const float*)(F.ws + WS_MOD); float* SHW = (float*)(F.ws + WS_SHW);
#ifndef REP_SHW
#define REP_SHW 1
#endif
    for (int rp_ = 0; rp_ < REP_SHW; ++rp_)
    for (int it = F.vcu; it < 248; it += F.G) {
        if (it < 62) { const int l = it / 31, n0 = (it % 31) * 100;
            gemv8_item(F, MOD + (size_t)l * 8 * 6144, 6144, false, args.in[I_AWIN] + (size_t)l * 1024 * A_PROJ + n0, A_PROJ, (n0 + 100 <= A_PROJ) ? 100 : A_PROJ - n0, SHW + SHW_IN + (size_t)l * 8 * A_PROJ + n0, A_PROJ, nullptr); }
        else if (it < 226) { const int r = it - 62, l = r / 41, n0 = (r % 41) * 100;
            gemv8_item(F, MOD + (size_t)l * 8 * 6144 + 3072, 6144, false, args.in[I_W1] + (size_t)l * 1024 * 4096 + n0, 4096, (n0 + 100 <= 4096) ? 100 : 4096 - n0, SHW + SHW_UP + (size_t)l * 8 * 4096 + n0, 4096, nullptr); }
        else { const int r = it - 226, j = r / 11, n0 = (r % 11) * 100;
            gemv8_item(F, MOD + (size_t)(NA + j) * 8 * 6144, 6144, false, args.in[I_WQ] + (size_t)j * 1024 * 1024 + n0, 1024, (n0 + 100 <= 1024) ? 100 : 1024 - n0, SHW + SHW_Q + (size_t)j * 8 * 1024 + n0, 1024, nullptr); }
    }
    bf16* XN = (bf16*)(F.ws + WS_XN); float* SS0 = (float*)(F.ws + WS_SS);
    for (int m = gw; m < M; m += 2 * NGW) {
        const int m2 = (m + NGW < M) ? m + NGW : m;
        const f32x4* xa = (const f32x4*)(args.in[I_X] + (size_t)m * D) + F.lane; const f32x4* xb = (const f32x4*)(args.in[I_X] + (size_t)m2 * D) + F.lane;
        f32x4 va[4], vb[4];
#pragma unroll
        for (int j = 0; j < 4; ++j) { va[j] = xa[64 * j]; vb[j] = xb[64 * j]; }
        const float* sca = MOD + (size_t)(m >> 11) * 6144 + 1024; const float* scb = MOD + (size_t)(m2 >> 11) * 6144 + 1024;
        v2u* oa = (v2u*)(XN + (size_t)m * D) + F.lane; v2u* ob = (v2u*)(XN + (size_t)m2 * D) + F.lane; float sa = 0.f, sb = 0.f;
#pragma unroll
        for (int j = 0; j < 4; ++j) { sa += (va[j].x * va[j].x + va[j].y * va[j].y) + (va[j].z * va[j].z + va[j].w * va[j].w); sb += (vb[j].x * vb[j].x + vb[j].y * vb[j].y) + (vb[j].z * vb[j].z + vb[j].w * vb[j].w);
            const f32x4 ya = va[j] * (*((const f32x4*)sca + F.lane + 64 * j) + 1.0f), yb = vb[j] * (*((const f32x4*)scb + F.lane + 64 * j) + 1.0f);
            oa[64 * j] = (v2u){pk2(ya.x, ya.y), pk2(ya.z, ya.w)}; ob[64 * j] = (v2u){pk2(yb.x, yb.y), pk2(yb.z, yb.w)}; }
#pragma unroll
        for (int o = 1; o < 64; o <<= 1) { sa += shfl_i(sa, F.lane ^ o); sb += shfl_i(sb, F.lane ^ o); }
        if (F.lane == 0) { SS0[m] = sa; SS0[m2] = sb; }
    }
}

template <int NG> __device__ __forceinline__ void gates_pass(Frame& F, int l) {
    const int gw = F.vcu * NWAVES + F.wave, NGW = F.G * NWAVES;
    LAS float* wg = (LAS float*)F.lds;
    { const f32x4* src = (const f32x4*)((const float*)(F.ws + WS_PAR) + (NG == 8 ? PG_IN + l * 8192 : PG_KV)); for (int i = F.tid; i < NG * 256; i += 512) ((LAS f32x4*)wg)[i] = src[i]; }
    __syncthreads();
    const float* PAR = (const float*)(F.ws + WS_PAR);
    const bf16* A = (NG == 8) ? (const bf16*)(F.ws + WS_XN) : (const bf16*)(F.ws + WS_KVN);
    const float* SS = (const float*)(F.ws + WS_SS) + (size_t)(2 * l) * M;
    const float* shw = (const float*)(F.ws + WS_SHW) + SHW_IN + (size_t)l * 8 * A_PROJ + 3072;
    for (int m0 = gw; m0 < M; m0 += 2 * NGW) {
        asm volatile("" ::: "memory");
        const int m1 = (m0 + NGW < M) ? m0 + NGW : m0;
        const v2u* ar0 = (const v2u*)(A + (size_t)m0 * D) + F.lane; const v2u* ar1 = (const v2u*)(A + (size_t)m1 * D) + F.lane;
        f32x4 y0[4], y1[4];
#pragma unroll
        for (int j = 0; j < 4; ++j) { const v2u a = ar0[64 * j], b = ar1[64 * j]; y0[j] = (f32x4){bflo(a.x), bfhi(a.x), bflo(a.y), bfhi(a.y)}; y1[j] = (f32x4){bflo(b.x), bfhi(b.x), bflo(b.y), bfhi(b.y)}; }
        const float r0 = __builtin_amdgcn_rsqf(SS[m0] * (1.0f / D) + EPS), r1 = __builtin_amdgcn_rsqf(SS[m1] * (1.0f / D) + EPS);
        float pg0[NG], pg1[NG];
#pragma unroll
        for (int g = 0; g < NG; ++g) { float p = 0.f, q = 0.f;
#pragma unroll
            for (int j = 0; j < 4; ++j) { const f32x4 w = *((const LAS f32x4*)(wg + g * 1024) + F.lane + 64 * j);
                p += (y0[j].x * w.x + y0[j].y * w.y) + (y0[j].z * w.z + y0[j].w * w.w); q += (y1[j].x * w.x + y1[j].y * w.y) + (y1[j].z * w.z + y1[j].w * w.w); }
            pg0[g] = p; pg1[g] = q; }
#pragma unroll
        for (int o = 1; o < 64; o <<= 1) {
#pragma unroll
            for (int g = 0; g < NG; ++g) { pg0[g] += shfl_i(pg0[g], F.lane ^ o); pg1[g] += shfl_i(pg1[g], F.lane ^ o); } }
        float mine0 = 0.f, mine1 = 0.f;
#pragma unroll
        for (int g = 0; g < NG; ++g) if (F.lane == g) { mine0 = pg0[g]; mine1 = pg1[g]; }
#pragma unroll
        for (int rr = 0; rr < 2; ++rr) { const int m = rr ? m1 : m0; const float r = rr ? r1 : r0, mine = rr ? mine1 : mine0;
            if (rr == 1 && m1 == m0) break;
            if (NG == 8) {
                if (F.lane < 8) { const float pre = r * mine + shw[(size_t)(m >> 11) * A_PROJ + F.lane];
                    if (F.lane < 4) ((float*)(F.ws + WS_IG))[(size_t)m * 4 + F.lane] = pre + PAR[PBI + l * 4 + F.lane];
                    else ((float*)(F.ws + WS_LF))[(size_t)m * 4 + F.lane - 4] = logsigmoidf_(pre + PAR[PBF + l * 4 + F.lane - 4]); }
            } else {
                if (F.lane < 16) ((float*)(F.ws + WS_LF16))[(size_t)m * 16 + F.lane] = logsigmoidf_(r * mine + PAR[PFGB + F.lane]);
            } }
    }
    __syncthreads();
}
__device__ __forceinline__ void fox_cumsum(Frame& F) {
    const int gw = F.vcu * NWAVES + F.wave, NGW = F.G * NWAVES;
    const float* LF16 = (const float*)(F.ws + WS_LF16); float* F2 = (float*)(F.ws + WS_F2);
    for (int bh = gw; bh < BATCH * 16; bh += NGW) {
        const int b = bh >> 4, h = bh & 15; const float* src = LF16 + ((size_t)b * SEQ + 32 * F.lane) * 16 + h;
        float tot = 0.f;
        for (int i = 0; i < 32; ++i) tot += src[i * 16];
        float inc = tot;
#pragma unroll
        for (int o = 1; o < 64; o <<= 1) { const float t = shfl_i(inc, (F.lane - o) & 63); if (F.lane >= o) inc += t; }
        float run = inc - tot; float* dst = F2 + (size_t)bh * SEQ + 32 * F.lane;
        for (int i = 0; i < 32; ++i) { run += src[i * 16]; dst[i] = run * LOG2E; }
    }
}
__device__ __forceinline__ void final_phase(Frame& F) {
    const int gw = F.vcu * NWAVES + F.wave, NGW = F.G * NWAVES;
    const float* SS = (const float*)(F.ws + WS_SS) + (size_t)8 * M;
    for (int m = gw; m < M; m += NGW) {
        f32x4* xr = (f32x4*)(F.X + (size_t)m * D) + F.lane;
        const float r = __builtin_amdgcn_rsqf(SS[m] * (1.0f / D) + EPS);
#pragma unroll
        for (int j = 0; j < 4; ++j) { const f32x4 gn = *((const f32x4*)((const float*)(F.ws + WS_PAR) + PFG) + F.lane + 64 * j); xr[64 * j] = xr[64 * j] * r * gn; }
    }
}
__device__ __forceinline__ void mlstm_post(Frame& F, int l) {
    const int gw = F.vcu * NWAVES + F.wave, NGW = F.G * NWAVES;
    const bf16* HT = (const bf16*)(F.ws + WS_HT); const bf16* OA = (const bf16*)(F.ws + WS_OA); bf16* G = (bf16*)(F.ws + WS_G);
    const float* hg = (const float*)(F.ws + WS_PAR) + PHG + (size_t)l * 1024;
    for (int m = gw; m < M; m += NGW) {
        const v2u* hr = (const v2u*)(HT + (size_t)m * D) + F.lane; const v2u* orow = (const v2u*)(OA + (size_t)m * D) + F.lane; v2u* gr = (v2u*)(G + (size_t)m * D) + F.lane;
        v2u hv[4], ov[4]; float ssq[4];
#pragma unroll
        for (int j = 0; j < 4; ++j) { hv[j] = hr[64 * j]; ov[j] = orow[64 * j];
            const float h0 = bflo(hv[j].x), h1 = bfhi(hv[j].x), h2 = bflo(hv[j].y), h3 = bfhi(hv[j].y); ssq[j] = (h0 * h0 + h1 * h1) + (h2 * h2 + h3 * h3); }
#pragma unroll
        for (int o = 1; o < 64; o <<= 1) {
#pragma unroll
            for (int j = 0; j < 4; ++j) ssq[j] += shfl_i(ssq[j], F.lane ^ o); }
#pragma unroll
        for (int j = 0; j < 4; ++j) { const float h0 = bflo(hv[j].x), h1 = bfhi(hv[j].x), h2 = bflo(hv[j].y), h3 = bfhi(hv[j].y);
            const float r = __builtin_amdgcn_rsqf(ssq[j] * (1.0f / 256.0f) + EPS);
            const f32x4 gn = *((const f32x4*)hg + F.lane + 64 * j);
            gr[64 * j] = (v2u){pk2(bflo(ov[j].x) * h0 * r * gn.x, bfhi(ov[j].x) * h1 * r * gn.y), pk2(bflo(ov[j].y) * h2 * r * gn.z, bfhi(ov[j].y) * h3 * r * gn.w)}; }
    }
}

#define LDS_BARRIER() asm volatile("s_waitcnt lgkmcnt(0)\n\ts_barrier" ::: "memory")
typedef short s16x4_t __attribute__((ext_vector_type(4)));
__device__ __forceinline__ bf16x8 tr8(const LAS unsigned char* p0, const LAS unsigned char* p1) {
    const s16x4_t a = __builtin_bit_cast(s16x4_t, __builtin_amdgcn_ds_read_tr16_b64_v4i16((LAS s16x4_t*)p0)), b = __builtin_bit_cast(s16x4_t, __builtin_amdgcn_ds_read_tr16_b64_v4i16((LAS s16x4_t*)p1));
    return (bf16x8){a[0], a[1], a[2], a[3], b[0], b[1], b[2], b[3]};
}
__device__ __forceinline__ void mlstm_phase(Frame& F, int l) {
    constexpr int QP = 144, VP = 80, CP = 136, PP = 72;
    constexpr int OQ = 0, OK0 = 18432, OV = 3 * 18432, OVW0 = OV + 10240, OCT = OVW0 + 2 * 10240, OP = OCT + 48 * CP * 2;
    constexpr int OG = OP + 64 * PP * 2;
    constexpr int ORS = OG + 3 * 32 * 64 * 4;
    static_assert(ORS + 512 <= MISC_OFF, "mlstm LDS");
    LAS unsigned char* L = F.lds;
    const int tid = F.tid, lane = F.lane, w = F.wave, fr = lane & 15, fq = lane >> 4;
    const bf16* QA = (const bf16*)(F.ws + WS_QA); const bf16* KA = (const bf16*)(F.ws + WS_KA); const bf16* VA = (const bf16*)(F.ws + WS_VA); bf16* HT = (bf16*)(F.ws + WS_HT);
    const bf16* OAp = (const bf16*)(F.ws + WS_OA); float* HS = (float*)(F.ws + WS_HS) + (size_t)l * M * 4; const float* hgp = (const float*)(F.ws + WS_PAR) + PHG + (size_t)l * 1024;
    const float* IG = (const float*)(F.ws + WS_IG); const float* LF = (const float*)(F.ws + WS_LF);
    const int trq = (lane & 15) >> 2, trp = lane & 3;
    for (int item = F.vcu; item < 256; item += F.G) {
        const int b = item >> 5, h = (item >> 3) & 3, dvs = item & 7;
        const int gcol = h * 256 + dvs * 32 + 16 * (w & 1) + fr; const float gain = hgp[gcol];
        __syncthreads();
        for (int i = tid; i < 48 * CP / 2; i += 512) ((LAS unsigned*)(L + OCT))[i] = 0u;
        if (tid < 64) {
            LAS v4u* p = (LAS v4u*)(L + OV + tid * VP * 2 + 64); ((LAS unsigned*)p)[0] = 0x3f80u + (unsigned)(F.G >> 30);     ((LAS unsigned*)p)[1] = 0u; ((LAS unsigned*)p)[2] = 0u; ((LAS unsigned*)p)[3] = 0u; ((LAS unsigned*)p)[4] = 0u; ((LAS unsigned*)p)[5] = 0u; ((LAS unsigned*)p)[6] = 0u; ((LAS unsigned*)p)[7] = 0u;
            LAS v4u* p1 = (LAS v4u*)(L + OVW0 + tid * VP * 2 + 64); p1[0] = (v4u){0u, 0u, 0u, 0u}; p1[1] = (v4u){0u, 0u, 0u, 0u};
            LAS v4u* p2 = (LAS v4u*)(L + OVW0 + 10240 + tid * VP * 2 + 64); p2[0] = (v4u){0u, 0u, 0u, 0u}; p2[1] = (v4u){0u, 0u, 0u, 0u}; }
        f32x4 accC[3]; accC[0] = (f32x4){0.f, 0.f, 0.f, 0.f}; accC[1] = accC[0]; accC[2] = accC[0];
        float mst = 0.f;
        v4u nq[2], nk[2], nv = (v4u){0u, 0u, 0u, 0u};
#define ML_LOAD(t0_) do { _Pragma("unroll") for (int i = 0; i < 2; ++i) { const int p = tid + 512 * i; \
            nq[i] = *(const v4u*)(QA + ((t0_) + (p >> 4)) * 512 + h * 128 + (p & 15) * 8); nk[i] = *(const v4u*)(KA + ((t0_) + (p >> 4)) * 512 + h * 128 + (p & 15) * 8); } \
            if (w < 4) nv = *(const v4u*)(VA + ((t0_) + (tid >> 2)) * 1024 + h * 256 + dvs * 32 + (tid & 3) * 8); \
            } while (0)
        float g_u, g_M, g_wi, g_em, g_decay, g_ML, g_bL;
        {
          float pb[4], pu[4], pc[4];
#pragma unroll
          for (int q = 0; q < 4; ++q) { const size_t tk = (size_t)b * SEQ + (size_t)(w + 8 * q) * 64 + lane; pb[q] = LF[tk * 4 + h]; pu[q] = IG[tk * 4 + h]; }
#pragma unroll
          for (int o = 1; o < 64; o <<= 1) {
#pragma unroll
              for (int q = 0; q < 4; ++q) { const float t = shfl_i(pb[q], (lane - o) & 63); if (lane >= o) pb[q] += t; } }
#pragma unroll
          for (int q = 0; q < 4; ++q) { pu[q] -= pb[q]; pc[q] = pu[q]; }
#pragma unroll
          for (int o = 1; o < 64; o <<= 1) {
#pragma unroll
              for (int q = 0; q < 4; ++q) { const float t = shfl_i(pc[q], (lane - o) & 63); if (lane >= o) pc[q] = fmaxf(pc[q], t); } }
#pragma unroll
          for (int q = 0; q < 4; ++q) { LAS float* gp = (LAS float*)(L + OG) + (w + 8 * q) * 64 + lane; gp[0] = pb[q]; gp[2048] = pu[q]; gp[4096] = pc[q]; }
        }
        __syncthreads();
#define ML_STAGE(kb_, cn_) do { const LAS float* gp_ = (const LAS float*)(L + OG) + (cn_) * 64 + lane; const float bc = gp_[0]; g_u = gp_[2048]; const float cm = gp_[4096]; \
            g_M = fmaxf(mst, cm); g_ML = __int_as_float(__builtin_amdgcn_readlane(__float_as_int(g_M), 63)); g_bL = __int_as_float(__builtin_amdgcn_readlane(__float_as_int(bc), 63)); \
            const float wl = __expf(g_u - g_ML); g_decay = __expf(mst - g_ML); g_wi = __expf(mst - g_M); g_em = __expf(-(bc + g_M)); \
            _Pragma("unroll") for (int i = 0; i < 2; ++i) { const int p = tid + 512 * i; \
                *(LAS v4u*)(L + OQ + (p >> 4) * QP * 2 + (p & 15) * 16) = nq[i]; *(LAS v4u*)(L + OK0 + (kb_) * 18432 + (p >> 4) * QP * 2 + (p & 15) * 16) = nk[i]; } \
            if (w < 4) { const int row = tid >> 2; const float ws = shfl_i(wl, row); \
                *(LAS v4u*)(L + OV + row * VP * 2 + (tid & 3) * 16) = nv; \
                *(LAS v4u*)(L + OVW0 + (kb_) * 10240 + row * VP * 2 + (tid & 3) * 16) = (v4u){pk2(bflo(nv.x) * ws, bfhi(nv.x) * ws), pk2(bflo(nv.y) * ws, bfhi(nv.y) * ws), pk2(bflo(nv.z) * ws, bfhi(nv.z) * ws), pk2(bflo(nv.w) * ws, bfhi(nv.w) * ws)}; \
                if (w == 0) *(LAS bf16*)(L + OVW0 + (kb_) * 10240 + lane * VP * 2 + 64) = (bf16)f2bf(wl); } } while (0)
        { const size_t t0 = (size_t)b * SEQ; ML_LOAD(t0); }
        ML_STAGE(0, 0);
        unsigned short so[4];
#pragma unroll
        for (int r = 0; r < 4; ++r) so[r] = OAp[((size_t)b * SEQ + 16 * (w >> 1) + 4 * fq + r) * 1024 + gcol];
        for (int c = 0; c < SEQ / 64; ++c) {
            const int kb = c & 1; const size_t tok0 = (size_t)b * SEQ + (size_t)c * 64;
            const float decay = g_decay; const float mnew = g_bL + g_ML; const float mcur = mst;
            const int ti = w >> 1, ej = w & 1;
            float gb_t[4], gc_t[4], gu_s[2];
            { const LAS float* gt = (const LAS float*)(L + OG) + c * 64;
#pragma unroll
              for (int r = 0; r < 4; ++r) { gb_t[r] = gt[16 * ti + 4 * fq + r]; gc_t[r] = gt[4096 + 16 * ti + 4 * fq + r]; }
#pragma unroll
              for (int jj = 0; jj < 2; ++jj) gu_s[jj] = gt[2048 + 16 * (2 * (w & 1) + jj) + fr]; }
            if (c + 1 < SEQ / 64) { const size_t t1 = tok0 + 64; ML_LOAD(t1); }
            LDS_BARRIER();
#pragma unroll
            for (int jj = 0; jj < 2; ++jj) { const int sj = 2 * (w & 1) + jj; f32x4 acc = (f32x4){0.f, 0.f, 0.f, 0.f};
                if (sj <= ti) {
#pragma unroll
                    for (int ks = 0; ks < 4; ++ks) { const bf16x8 a = *(const LAS bf16x8*)(L + OQ + (16 * ti + fr) * QP * 2 + ks * 64 + fq * 16), bq = *(const LAS bf16x8*)(L + OK0 + kb * 18432 + (16 * sj + fr) * QP * 2 + ks * 64 + fq * 16);
                        acc = __builtin_amdgcn_mfma_f32_16x16x32_bf16(a, bq, acc, 0, 0, 0); } }
                const int s_ = 16 * sj + fr; const float us = gu_s[jj];
#pragma unroll
                for (int r = 0; r < 4; ++r) { const int t = 16 * ti + 4 * fq + r; const float e = __expf(fminf(us - fmaxf(mcur, gc_t[r]), 0.f));
                    *(LAS bf16*)(L + OP + t * PP * 2 + s_ * 2) = (bf16)f2bf(s_ <= t ? acc[r] * e : 0.f); } }
            LDS_BARRIER();
            f32x4 a1n = (f32x4){0.f, 0.f, 0.f, 0.f}, a1d = a1n, a2n = a1n, a2d = a1n;
#pragma unroll
            for (int ks = 0; ks < 4; ++ks) { const bf16x8 a = *(const LAS bf16x8*)(L + OQ + (16 * ti + fr) * QP * 2 + ks * 64 + fq * 16);
                const bf16x8 bn = *(const LAS bf16x8*)(L + OCT + (16 * ej + fr) * CP * 2 + ks * 64 + fq * 16), bd = *(const LAS bf16x8*)(L + OCT + (32 + fr) * CP * 2 + ks * 64 + fq * 16);
                a1n = __builtin_amdgcn_mfma_f32_16x16x32_bf16(a, bn, a1n, 0, 0, 0); a1d = __builtin_amdgcn_mfma_f32_16x16x32_bf16(a, bd, a1d, 0, 0, 0); }
#pragma unroll
            for (int ks = 0; ks < 2; ++ks) { const bf16x8 a = *(const LAS bf16x8*)(L + OP + (16 * ti + fr) * PP * 2 + ks * 64 + fq * 16);
                const LAS unsigned char* vb = L + OV + (32 * ks + 8 * fq + trq) * VP * 2 + trp * 8;
                const bf16x8 bn = tr8(vb + 32 * ej, vb + 4 * VP * 2 + 32 * ej), bd = tr8(vb + 64, vb + 4 * VP * 2 + 64);
                a2n = __builtin_amdgcn_mfma_f32_16x16x32_bf16(a, bn, a2n, 0, 0, 0); a2d = __builtin_amdgcn_mfma_f32_16x16x32_bf16(a, bd, a2d, 0, 0, 0); }
            asm volatile("s_waitcnt lgkmcnt(0)" ::: "memory");
            LDS_BARRIER();
            float q4[4];
#pragma unroll
            for (int r = 0; r < 4; ++r) { const int t = 16 * ti + 4 * fq + r; const float Mt_ = fmaxf(mcur, gc_t[r]); const float wit = __expf(mcur - Mt_), emt = __expf(-(gb_t[r] + Mt_));
                const float den = shfl_i(wit * a1d[r] + a2d[r], lane & 48);
                const float hv = (wit * a1n[r] + a2n[r]) * __builtin_amdgcn_rcpf(fmaxf(fabsf(den), emt));
                q4[r] = hv * hv; HT[(tok0 + t) * 1024 + gcol] = (bf16)f2bf(hv * bf1(so[r]) * gain); }
#pragma unroll
            for (int r = 0; r < 4; ++r) { float q = q4[r];
                q += __int_as_float(__builtin_amdgcn_mov_dpp(__float_as_int(q), 0xB1, 0xF, 0xF, true));
                q += __int_as_float(__builtin_amdgcn_mov_dpp(__float_as_int(q), 0x4E, 0xF, 0xF, true));
                q += __int_as_float(__builtin_amdgcn_mov_dpp(__float_as_int(q), 0x141, 0xF, 0xF, true));
                q += __int_as_float(__builtin_amdgcn_mov_dpp(__float_as_int(q), 0x140, 0xF, 0xF, true));
                q4[r] = q; }
            if (c + 1 < SEQ / 64) {
#pragma unroll
                for (int r = 0; r < 4; ++r) so[r] = OAp[(tok0 + 64 + 16 * ti + 4 * fq + r) * 1024 + gcol]; }
            { const float mq = fr == 0 ? q4[0] : fr == 1 ? q4[1] : fr == 2 ? q4[2] : q4[3];
              if (fr < 4) (void)__hip_atomic_fetch_add(HS + (size_t)h * M + tok0 + 16 * ti + 4 * fq + fr, mq, __ATOMIC_RELAXED, __HIP_MEMORY_SCOPE_AGENT); }
#pragma unroll
            for (int ks = 0; ks < 2; ++ks) { const LAS unsigned char* kbp = L + OK0 + kb * 18432 + (32 * ks + 8 * fq + trq) * QP * 2 + 32 * w + trp * 8;
                const bf16x8 bk = tr8(kbp, kbp + 4 * QP * 2);
                const LAS unsigned char* vwp = L + OVW0 + kb * 10240 + (32 * ks + 8 * fq + trq) * VP * 2 + trp * 8;
#pragma unroll
                for (int ei = 0; ei < 3; ++ei) { const bf16x8 av = tr8(vwp + 32 * ei, vwp + 4 * VP * 2 + 32 * ei);
                    if (ks == 0) accC[ei] = accC[ei] * decay;
                    accC[ei] = __builtin_amdgcn_mfma_f32_16x16x32_bf16(av, bk, accC[ei], 0, 0, 0); } }
#pragma unroll
            for (int ei = 0; ei < 3; ++ei)
#pragma unroll
                for (int r = 0; r < 4; ++r) *(LAS bf16*)(L + OCT + (16 * ei + 4 * fq + r) * CP * 2 + (16 * w + fr) * 2) = (bf16)f2bf(accC[ei][r]);
            mst = mnew;
            if (c + 1 < SEQ / 64) ML_STAGE(kb ^ 1, c + 1);
        }
#undef ML_LOAD
#undef ML_STAGE
    }
}

#ifndef PHMASK
#define PHMASK 0xffff
#endif
#define PH_EN(b) (((PHMASK) >> (b)) & 1)
__global__ void __launch_bounds__(NWAVES * 64, 2) yoco_fwd(Args args) {
    extern __shared__ __attribute__((aligned(16))) unsigned char lds[];
    Frame F;
    F.lds = (LAS unsigned char*)lds;
    const int wv0 = __builtin_amdgcn_readfirstlane((int)threadIdx.x >> 6);
    { const int t0_ = (wv0 << 6) + (int)__builtin_amdgcn_mbcnt_hi(~0u, __builtin_amdgcn_mbcnt_lo(~0u, 0u));
      volatile LAS unsigned* misc = (volatile LAS unsigned*)((LAS unsigned char*)lds + MISC_OFF); if (t0_ < 32) misc[t0_] = 0u;
      __syncthreads();
      (void)xcd_barrier_post((unsigned*)(args.ws + WS_BAR), (volatile LAS unsigned*)((LAS unsigned char*)lds + MISC_OFF) + 8, t0_); }
#ifdef PROBE_MASK
    unsigned long long tacc = 0ull;
#endif
#pragma nounroll
    for (int ph = args.ph_lo; ph < args.ph_hi; ++ph) {
#ifdef PROBE_MASK
        const unsigned long long tp0 = __builtin_amdgcn_s_memrealtime();
#endif
        { int zz = 0; asm volatile("" : "+s"(zz)); zz = __builtin_amdgcn_readfirstlane(zz);
          const int gx = (int)gridDim.x + zz, bx = (int)blockIdx.x + zz, tx = (wv0 << 6) + (int)__builtin_amdgcn_mbcnt_hi(~0u, __builtin_amdgcn_mbcnt_lo(~0u, (unsigned)zz));
          F.X = args.out + zz; F.ws = args.ws + zz; F.G = gx; F.bx = bx; F.vcu = (gx % 8 == 0) ? (bx % 8) * (gx / 8) + bx / 8 : bx;
          F.tid = tx; F.lane = tx & 63; F.wave = __builtin_amdgcn_readfirstlane(tx >> 6); }
        const float* MOD = (const float*)(F.ws + WS_MOD);
        bf16* XN = (bf16*)(F.ws + WS_XN);
        const float* SSb = (const float*)(F.ws + WS_SS); const float* SHW = (const float*)(F.ws + WS_SHW);
        if (ph == 0) p0_prologue(F, args);
        else if (ph == 1) p1_prologue(F, args);
        else if (ph == NPH - 1) final_phase(F);
        else {
            const int l = (ph - 2) / 6, sub = (ph - 2) % 6; const bool isA = l < NA;
            if (sub == 0) {
                if (isA) {
                    gates_pass<8>(F, l);
                    pg8::Gemm g{XN, (const bf16*)(F.ws + WS_WIN) + (size_t)l * 3072 * 1024, M, 3072, D}; pg8::StaticOrder S; S.init(M, 3072, F.G, F.bx);
                    pg8::EpiStore<0> E{(bf16*)(F.ws + WS_QA), (bf16*)(F.ws + WS_KA), (bf16*)(F.ws + WS_VA), (bf16*)(F.ws + WS_OA), SSb + (size_t)(2 * l) * M, SHW + SHW_IN + (size_t)l * 8 * A_PROJ, 0.08838834764831845f, A_PROJ};
                    pg8::gemm_phase<pg8::EpiStore<0>, pg8::StaticOrder, true, true>(F.lds, g, S, E, F.tid);
                } else {
                    if (l == NA) gates_pass<16>(F, l);
                    { pg8::Gemm g{XN, (const bf16*)(F.ws + WS_WQ) + (size_t)(l - NA) * 1024 * 1024, M, D, D}; pg8::StaticOrder S; S.init(M, D, F.G, F.bx);
                      pg8::EpiStore<1> E{(bf16*)(F.ws + WS_QO), nullptr, nullptr, nullptr, SSb + (size_t)(2 * l) * M, SHW + SHW_Q + (size_t)(l - NA) * 8 * 1024, 0.18033688011112042f, 1024};
                      pg8::gemm_phase<pg8::EpiStore<1>, pg8::StaticOrder, true, true>(F.lds, g, S, E, F.tid); }
                    if (l == NA) { pg8::Gemm g{(const bf16*)(F.ws + WS_KVN), (const bf16*)(F.ws + WS_WKV), M, 2048, D}; pg8::StaticOrder S; S.init(M, 2048, F.G, F.bx);
                      pg8::EpiStore<2> E{(bf16*)(F.ws + WS_KF), (bf16*)(F.ws + WS_VF), nullptr, nullptr, SSb + (size_t)(2 * l) * M, nullptr, 1.f, 0};
                      pg8::gemm_phase<pg8::EpiStore<2>, pg8::StaticOrder, true, true>(F.lds, g, S, E, F.tid); }
                }
            }
            else if (sub == 1) { if (isA) mlstm_phase(F, l); else continue; }
            else if (sub == 2) {
                if (isA) continue;
                else { const attn_body::AttnTensors AT{(const attn_body::bf16*)(F.ws + WS_QO), (const attn_body::bf16*)(F.ws + WS_KF), (const attn_body::bf16*)(F.ws + WS_VF), (attn_body::bf16*)(F.ws + WS_QO), (const float*)(F.ws + WS_LF16)};
                    const attn_body::StaticOrder S((int)F.G, F.vcu);
#ifdef ATTN_EXP
#pragma nounroll
                    for (int rep_ = 0; rep_ < 2; ++rep_) {
                        const attn_body::AttnTensors AD{(const attn_body::bf16*)(F.ws + WS_QO), (const attn_body::bf16*)(F.ws + WS_KF), (const attn_body::bf16*)(F.ws + WS_VF), (attn_body::bf16*)(F.ws + (rep_ ? WS_QO : WS_KVN)), (const float*)(F.ws + WS_LF16)};
                        const attn_body::StaticOrder S2((int)F.G, F.vcu, (rep_ == 0 && ATTN_EXP >= 10) ? ATTN_EXP - 10 : -1);
                        attn_body::attn_phase<attn_body::StaticOrder>((char*)lds, AD, S2, F.tid, rep_ == 0 && ATTN_EXP == 1); }
                    }
#else
                    attn_body::attn_phase<attn_body::StaticOrder>((char*)lds, AT, S, F.tid); }
#endif
            }
            else if (sub == 3 || sub == 5) {
                const bool dn = (sub == 5);
                const bf16* A = dn ? (const bf16*)(F.ws + WS_H) : (isA ? (const bf16*)(F.ws + WS_HT) : (const bf16*)(F.ws + WS_QO));
                const bf16* Bt = dn ? (const bf16*)(F.ws + WS_W2) + (size_t)l * 1024 * 4096 : (isA ? (const bf16*)(F.ws + WS_WAO) + (size_t)l * 1024 * 1024 : (const bf16*)(F.ws + WS_WBO) + (size_t)(l - NA) * 1024 * 1024);
                pg8::Gemm g{A, Bt, M, D, dn ? FF : D}; pg8::StaticOrder S; S.init(M, D, F.G, F.bx);
                const bool last = dn && (l == DEPTH - 1);
                const float* xin_ = (ph == 5) ? args.in[I_X] : (const float*)F.X;
                pg8::EpiRes E{xin_, F.X, MOD + (size_t)l * 8 * 6144 + (dn ? 5 : 2) * 1024,
                              (float*)(F.ws + WS_SS) + (size_t)(2 * l + (dn ? 2 : 1)) * M, last ? (bf16*)nullptr : XN,
                              dn ? MOD + (size_t)(l + 1) * 8 * 6144 + 1024 : MOD + (size_t)l * 8 * 6144 + 4 * 1024,
                              (dn && l == NA - 1) ? (bf16*)(F.ws + WS_KVN) : (bf16*)nullptr, (const float*)(F.ws + WS_PAR) + PKVG,
                              (isA && !dn) ? (const float*)(F.ws + WS_HS) + (size_t)l * M * 4 : (const float*)nullptr};
                pg8::gemm_phase<pg8::EpiRes, pg8::StaticOrder, true, true>(F.lds, g, S, E, F.tid);
            }
            else {
                pg8::Gemm g{XN, (const bf16*)(F.ws + WS_W1) + (size_t)l * 1024 * 4096, M, FF, D}; pg8::StaticOrder S; S.init(M, FF, F.G, F.bx);
                pg8::EpiStore<3> E{(bf16*)(F.ws + WS_H), nullptr, nullptr, nullptr, SSb + (size_t)(2 * l + 1) * M, SHW + SHW_UP + (size_t)l * 8 * 4096, 1.f, 4096};
                pg8::gemm_phase<pg8::EpiStore<3>, pg8::StaticOrder, true, true>(F.lds, g, S, E, F.tid);
            }
        }
        if (ph + 1 < args.ph_hi) { XcdBarrier bar; bar.bar = (unsigned*)(F.ws + WS_BAR); bar.x = xb_xcc_id(); bar.st = (volatile LAS unsigned*)(F.lds + MISC_OFF) + 8; xcd_barrier(bar, F.tid);
#ifdef EXTRA_BAR
            for (int eb_ = 0; eb_ < EXTRA_BAR; ++eb_) xcd_barrier(bar, F.tid);
#endif
        }
#ifdef PROBE_MASK
        { const int pb = (ph == 0) ? 8 : (ph == 1) ? 10 : (ph == NPH - 1) ? 9 : (((ph - 2) % 6) + ((ph - 2) / 6 >= NA ? 12 : 0)); if (((PROBE_MASK) >> pb) & 1) tacc += __builtin_amdgcn_s_memrealtime() - tp0; }
#endif
    }
#ifdef PROBE_MASK
    if (blockIdx.x == 0 && wv0 == 0 && __builtin_amdgcn_mbcnt_lo(~0u, 0u) == 0u) { const unsigned long long t0 = __builtin_amdgcn_s_memrealtime(); while (__builtin_amdgcn_s_memrealtime() - t0 < tacc) __builtin_amdgcn_s_sleep(16); }
#endif
}

#ifndef MK_N_LAUNCHES
#define MK_N_LAUNCHES 1
#endif
extern "C" void kernel_launch(void* const* d_in, const int* in_sizes, int n_in, void* d_out, int out_size, void* d_ws, size_t ws_size, hipStream_t stream) {
    static int grid = 0;
    if (grid == 0) {
        if (n_in != 17 || out_size != M * D || ws_size < WS_END) { fprintf(stderr, "kernel_launch: unexpected shapes: n_in %d out %d ws %zu\n", n_in, out_size, ws_size); grid = -1; return; }
        int dev = 0, cus = 0, per_cu = 0;
        if (hipGetDevice(&dev) != hipSuccess || hipDeviceGetAttribute(&cus, hipDeviceAttributeMultiprocessorCount, dev) != hipSuccess) { grid = -1; return; }
        if (hipFuncSetAttribute((const void*)yoco_fwd, hipFuncAttributeMaxDynamicSharedMemorySize, LDS_BYTES) != hipSuccess) { fprintf(stderr, "kernel_launch: hipFuncSetAttribute failed\n"); grid = -1; return; }
        if (hipOccupancyMaxActiveBlocksPerMultiprocessor(&per_cu, (const void*)yoco_fwd, NWAVES * 64, LDS_BYTES) != hipSuccess || per_cu < 1) { fprintf(stderr, "kernel_launch: occupancy query says %d\n", per_cu); per_cu = 1; }
        (void)hipGetLastError();
        grid = cus;
    }
    if (grid < 0) return;
    if (hipMemsetAsync((char*)d_ws + WS_BAR, 0, WS_BAR_BYTES, stream) != hipSuccess) { fprintf(stderr, "kernel_launch: memset failed\n"); return; }
    Args a{};
    for (int i = 0; i < 17; ++i) a.in[i] = (const float*)d_in[i];
    a.out = (float*)d_out; a.ws = (unsigned char*)d_ws;
#if MK_N_LAUNCHES == 1
    a.ph_lo = 0; a.ph_hi = NPH;
    void* kargs[] = {&a};
    hipError_t e = hipLaunchCooperativeKernel((const void*)yoco_fwd, dim3(grid), dim3(NWAVES * 64), kargs, LDS_BYTES, stream);
    if (e != hipSuccess) fprintf(stderr, "kernel_launch: cooperative launch failed: %s (grid %d)\n", hipGetErrorString(e), grid);
#else
    for (int ph = 0; ph < NPH; ++ph) { a.ph_lo = ph; a.ph_hi = ph + 1; hipLaunchKernelGGL(yoco_fwd, dim3(grid), dim3(NWAVES * 64), LDS_BYTES, stream, a); }
#endif
}
```

```cpp
#include <hip/hip_runtime.h>
#include <cstdio>
#include <cstdint>
namespace pg8 {
#define PG8_LAS __attribute__((address_space(3)))
typedef unsigned short bf16_t;
typedef short bf16x8 __attribute__((ext_vector_type(8)));
typedef float f32x4 __attribute__((ext_vector_type(4)));
typedef unsigned u32x4 __attribute__((ext_vector_type(4)));
constexpr int BM = 256, BK = 64, HALF = 128, HTB = HALF * BK * 2  , STAGE_BYTES = 8 * HTB, NXCD = 8, WGM = 8;

__host__ __device__ __forceinline__ int lds_byte(int r, int c) { const int st = (r >> 4) * 2 + (c >> 5), rr = r & 15, cc = c & 31, ob = rr * 64 + cc * 2; return st * 1024 + (ob ^ (((ob >> 9) & 1) << 5)); }
__host__ __device__ __forceinline__ void stage_rc(int b, int& R, int& C) { const int st = b / 1024, sb = b % 1024, swz = sb ^ (((sb >> 9) & 1) << 5); R = (st >> 1) * 16 + swz / 64; C = (st & 1) * 32 + (swz % 64) / 2; }
__host__ __device__ __forceinline__ int perm32(int rho) { const int n = rho >> 4, i = rho & 15; return 8 * (i >> 2) + 4 * n + (i & 3); }

struct Unit { int pm, pn; };
struct Gemm { const bf16_t* A; const bf16_t* Bt; int M, N, K; };

struct StaticOrder {
    int nM, nN, nwg, G, c;
    __host__ __device__ void init(int M, int N, int G_, int c_) { nM = M / BM; nN = N / BM; nwg = nM * nN; G = G_; c = c_; }
    __host__ __device__ bool next(int i, Unit& u) const {
        const long L = (long)i * G + c; if (L >= nwg) return false;
        int wgid = (int)L; { const int q = nwg / NXCD, r = nwg % NXCD, xcd = wgid % NXCD, off = wgid / NXCD; wgid = (xcd < r ? xcd * (q + 1) : r * (q + 1) + (xcd - r) * q) + off; }
        const int nig = WGM * nN, gid = wgid / nig, fm = gid * WGM, gsz = (nM - fm) < WGM ? (nM - fm) : WGM;
        u.pm = fm + ((wgid % nig) % gsz); u.pn = (wgid % nig) / gsz; return true;
    }
    __device__ __forceinline__ void a_ready(const Unit&) const {}
    __device__ __forceinline__ void done(const Unit&) const {}
};

__device__ __forceinline__ unsigned cvt_pk_bf16(float lo, float hi) { unsigned r; asm volatile("v_cvt_pk_bf16_f32 %0, %1, %2" : "=v"(r) : "v"(lo), "v"(hi)); return r; }
template <int KIND> struct EpiStore {
    static constexpr bool PERM = true, AFTER_DRAIN = false, KHOOK = false;
    bf16_t *P0, *P1, *P2, *P3; const float* ss; const float* shw; float s0; int shs;
    __device__ __forceinline__ void operator()(const f32x4 (&acc)[2][2][4][2], const Unit& u, int wr, int wc, int fr, int fq) const {
        bf16_t* base = P0; int ldc = 1024, colt = u.pn * BM; float sc = 1.f; int act = 0;
        if (KIND == 0) { const int pn = u.pn;
            if (pn < 2) { base = P0; ldc = 512; colt = pn * BM; sc = s0; }
            else if (pn < 4) { base = P1; ldc = 512; colt = (pn - 2) * BM; }
            else if (pn < 8) { base = P2; ldc = 1024; colt = (pn - 4) * BM; }
            else { base = P3; ldc = 1024; colt = (pn - 8) * BM; act = 1; } }
        else if (KIND == 1) { sc = s0; }
        else if (KIND == 2) { if (u.pn >= 4) { base = P1; colt = (u.pn - 4) * BM; } }
        else { ldc = 4096; act = 2; }
        const int row0 = u.pm * BM + wr * 64 + fr, col0 = colt + wc * 32 + 8 * fq, gcol0 = u.pn * BM + wc * 32 + 8 * fq;
        f32x4 sv[2][2];
#pragma unroll
        for (int bj = 0; bj < 2; ++bj)
#pragma unroll
            for (int n = 0; n < 2; ++n) sv[bj][n] = (KIND != 2) ? *(const f32x4*)(shw + (size_t)(u.pm >> 3) * shs + gcol0 + bj * HALF + 4 * n) : (f32x4){0.f, 0.f, 0.f, 0.f};
        float rr[2][4];
#pragma unroll
        for (int ai = 0; ai < 2; ++ai)
#pragma unroll
            for (int m = 0; m < 4; ++m) rr[ai][m] = ss[row0 + ai * HALF + m * 16];
#pragma unroll
        for (int ai = 0; ai < 2; ++ai)
#pragma unroll
            for (int m = 0; m < 4; ++m) { const int row = row0 + ai * HALF + m * 16; bf16_t* rowp = base + (size_t)row * ldc + col0;
                const float r = __builtin_amdgcn_rsqf(rr[ai][m] * (1.0f / 1024.0f) + 1e-6f);
#pragma unroll
                for (int bj = 0; bj < 2; ++bj) { f32x4 v0 = acc[ai][bj][m][0] * r + sv[bj][0], v1 = acc[ai][bj][m][1] * r + sv[bj][1];
                    if (act == 1) {
#pragma unroll
                        for (int i = 0; i < 4; ++i) { v0[i] = __builtin_amdgcn_rcpf(1.0f + __expf(-v0[i])); v1[i] = __builtin_amdgcn_rcpf(1.0f + __expf(-v1[i])); } }
                    if (act == 2) {
#pragma unroll
                        for (int i = 0; i < 4; ++i) { const float a = fmaxf(v0[i], 0.f), b = fmaxf(v1[i], 0.f); v0[i] = a * a; v1[i] = b * b; } }
                    v0 = v0 * sc; v1 = v1 * sc; u32x4 w; w.x = cvt_pk_bf16(v0[0], v0[1]); w.y = cvt_pk_bf16(v0[2], v0[3]); w.z = cvt_pk_bf16(v1[0], v1[1]); w.w = cvt_pk_bf16(v1[2], v1[3]);
                    *(u32x4*)(rowp + bj * HALF) = w; } }
    }
};
struct EpiRes {
    static constexpr bool PERM = true, AFTER_DRAIN = false, KHOOK = true;
    const float* Xin; float* Xout; const float* gate; float* ssn; bf16_t* xn; const float* scn; bf16_t* kvn; const float* kvg;
    const float* hs;
    __device__ __forceinline__ void khook(f32x4 (&acc)[2][2][4][2], const Unit& u, int t, int nt, int wr, int fr) const {
        if (!hs) return;
        if (((t + 2) & 3) != 0 || t + 2 >= nt) return;
        const int hd = ((t + 2) >> 2) - 1;
        const float* hb = hs + (size_t)hd * 16384 + (u.pm * BM + wr * 64 + fr);
#pragma unroll
        for (int ai = 0; ai < 2; ++ai)
#pragma unroll
            for (int m = 0; m < 4; ++m) { const float sa = hb[ai * HALF + m * 16], sb = hb[16384 + ai * HALF + m * 16];
                const float ratio = __builtin_amdgcn_rsqf(sa * (1.0f / 256.0f) + 1e-6f) * __builtin_amdgcn_sqrtf(sb * (1.0f / 256.0f) + 1e-6f);
#pragma unroll
                for (int bj = 0; bj < 2; ++bj)
#pragma unroll
                    for (int n = 0; n < 2; ++n) acc[ai][bj][m][n] = acc[ai][bj][m][n] * ratio;
                if (m & 1) asm volatile("" ::: "memory"); }
    }
    __device__ __forceinline__ void operator()(const f32x4 (&acc)[2][2][4][2], const Unit& u, int wr, int wc, int fr, int fq) const {
        const size_t boff = (size_t)(u.pm >> 3) * 6144;
        const int row0 = u.pm * BM + wr * 64 + fr, col0 = u.pn * BM + wc * 32 + 8 * fq, lane = fr + 16 * fq;
        f32x4 gv[2][2], cv[2][2];
#pragma unroll
        for (int bj = 0; bj < 2; ++bj)
#pragma unroll
            for (int n = 0; n < 2; ++n) { gv[bj][n] = *(const f32x4*)(gate + boff + col0 + bj * HALF + 4 * n);
                cv[bj][n] = *(const f32x4*)(scn + boff + col0 + bj * HALF + 4 * n) + 1.0f; }
#pragma unroll
        for (int ai = 0; ai < 2; ++ai) { float sqm[4];
#pragma unroll
            for (int mh = 0; mh < 2; ++mh) {
            f32x4 xp[2][2][2];
#pragma unroll
            for (int mm = 0; mm < 2; ++mm)
#pragma unroll
                for (int bj = 0; bj < 2; ++bj) { const size_t off_ = (size_t)(row0 + ai * HALF + (2 * mh + mm) * 16) * 1024 + col0 + bj * HALF; xp[mm][bj][0] = *(const f32x4*)(Xin + off_); xp[mm][bj][1] = *(const f32x4*)(Xin + off_ + 4); }
#pragma unroll
            for (int mm = 0; mm < 2; ++mm) { const int m = 2 * mh + mm; const int row = row0 + ai * HALF + m * 16; const size_t off = (size_t)row * 1024 + col0; float sq = 0.f;
                const float r3 = hs ? __builtin_amdgcn_rsqf(hs[(size_t)3 * 16384 + row] * (1.0f / 256.0f) + 1e-6f) : 1.0f;
#pragma unroll
                for (int bj = 0; bj < 2; ++bj) { f32x4 x0 = xp[mm][bj][0], x1 = xp[mm][bj][1];
                    x0 = x0 + gv[bj][0] * (acc[ai][bj][m][0] * r3); x1 = x1 + gv[bj][1] * (acc[ai][bj][m][1] * r3);
                    *(f32x4*)(Xout + off + bj * HALF) = x0; *(f32x4*)(Xout + off + bj * HALF + 4) = x1;
                    sq += (x0[0] * x0[0] + x0[1] * x0[1]) + (x0[2] * x0[2] + x0[3] * x0[3]) + (x1[0] * x1[0] + x1[1] * x1[1]) + (x1[2] * x1[2] + x1[3] * x1[3]);
                    if (xn) { const f32x4 a0 = x0 * cv[bj][0], a1 = x1 * cv[bj][1]; u32x4 w; w.x = cvt_pk_bf16(a0[0], a0[1]); w.y = cvt_pk_bf16(a0[2], a0[3]); w.z = cvt_pk_bf16(a1[0], a1[1]); w.w = cvt_pk_bf16(a1[2], a1[3]);
                        *(u32x4*)(xn + off + bj * HALF) = w; }
                    if (kvn) { const f32x4 k0 = x0 * *(const f32x4*)(kvg + col0 + bj * HALF), k1 = x1 * *(const f32x4*)(kvg + col0 + bj * HALF + 4); u32x4 w; w.x = cvt_pk_bf16(k0[0], k0[1]); w.y = cvt_pk_bf16(k0[2], k0[3]); w.z = cvt_pk_bf16(k1[0], k1[1]); w.w = cvt_pk_bf16(k1[2], k1[3]);
                        *(u32x4*)(kvn + off + bj * HALF) = w; } }
                sq += __int_as_float(__builtin_amdgcn_ds_bpermute((lane ^ 16) << 2, __float_as_int(sq)));
                sq += __int_as_float(__builtin_amdgcn_ds_bpermute((lane ^ 32) << 2, __float_as_int(sq)));
                sqm[m] = sq;
                }
            }
            { const float mine = fq == 0 ? sqm[0] : fq == 1 ? sqm[1] : fq == 2 ? sqm[2] : sqm[3];
              (void)__hip_atomic_fetch_add(ssn + (row0 - fr) + ai * HALF + lane, mine, __ATOMIC_RELAXED, __HIP_MEMORY_SCOPE_AGENT); } }
    }
};
template <class Epi, class Sched, bool ALIGN_EPI = false, bool SP2 = false>
__device__ __forceinline__ void gemm_phase(PG8_LAS unsigned char* lds, const Gemm g, const Sched& S, const Epi& E, const int tid_in) {
    const int tid = tid_in, wid = __builtin_amdgcn_readfirstlane(tid >> 6), lane = tid & 63, wr = wid >> 2, wc = wid & 3, fr = lane & 15, fq = lane >> 4;
    const int K = g.K, nt = K / BK;
    unsigned voffA[2], voffB[2];
#pragma unroll
    for (int i = 0; i < 2; ++i) { int R, C; stage_rc(tid * 16 + i * 8192, R, C); const int Rb = Epi::PERM ? ((R & ~31) + perm32(R & 31)) : R;
        voffA[i] = (unsigned)(R * K + C) * 2u; voffB[i] = (unsigned)(Rb * K + C) * 2u; }
    const size_t kstep = (size_t)(BK * 2);
    const size_t hstep = (size_t)HALF * K * 2;
    const size_t tstep = 2 * hstep;
    const unsigned ldsw = (unsigned)wid * 1024u;
    const int aoff = lds_byte(wr * 64 + fr, fq * 8), boff = lds_byte(wc * 32 + fr, fq * 8);
#define PG8_SA(b, h) (((b) * 2 + (h)) * HTB)
#define PG8_SB(b, h) ((4 + (b) * 2 + (h)) * HTB)
#define PG8_STAGE(bufoff, gbase, voff) do { _Pragma("unroll") for (int _i = 0; _i < 2; ++_i) \
        __builtin_amdgcn_global_load_lds((const unsigned*)((const char*)(gbase) + (voff)[_i]), (PG8_LAS unsigned*)(lds + (bufoff) + ldsw + _i * 8192), 16, 0, 0); } while (0)
#define PG8_LDA(dst, b, h) do { _Pragma("unroll") for (int m = 0; m < 4; ++m) _Pragma("unroll") for (int k = 0; k < 2; ++k) dst[m][k] = *(const PG8_LAS bf16x8*)(lds + PG8_SA(b, h) + aoff + m * 2048 + k * 1024); } while (0)
#define PG8_LDB(dst, b, h) do { _Pragma("unroll") for (int n = 0; n < 2; ++n) _Pragma("unroll") for (int k = 0; k < 2; ++k) dst[n][k] = *(const PG8_LAS bf16x8*)(lds + PG8_SB(b, h) + boff + n * 2048 + k * 1024); } while (0)
#define PG8_MMA(ai, bj, At, Bt) do { __builtin_amdgcn_s_setprio(1); _Pragma("unroll") for (int m = 0; m < 4; ++m) _Pragma("unroll") for (int n = 0; n < 2; ++n) _Pragma("unroll") for (int k = 0; k < 2; ++k) \
        acc[ai][bj][m][n] = __builtin_amdgcn_mfma_f32_16x16x32_bf16(Bt[n][k], At[m][k], acc[ai][bj][m][n], 0, 0, 0); __builtin_amdgcn_s_setprio(0); } while (0)
#define PG8_WAIT_V(n) asm volatile("s_waitcnt vmcnt(" #n ")" ::: "memory")
#define PG8_WAIT_L(n) asm volatile("s_waitcnt lgkmcnt(" #n ")" ::: "memory")
#define PG8_BAR __builtin_amdgcn_s_barrier()
#define PG8_SCHED __builtin_amdgcn_sched_barrier(0)
    Unit cur, nxt; int ui = 0;
    if (!S.next(0, cur)) return;
    f32x4 acc[2][2][4][2];
#pragma unroll
    for (int a = 0; a < 2; ++a)
#pragma unroll
        for (int b = 0; b < 2; ++b)
#pragma unroll
            for (int m = 0; m < 4; ++m)
#pragma unroll
                for (int n = 0; n < 2; ++n) acc[a][b][m][n] = (f32x4){0.f, 0.f, 0.f, 0.f};
    bf16x8 At[4][2], B0[2][2], B1[2][2];
    const char* cA = (const char*)g.A + (size_t)cur.pm * tstep; const char* cB = (const char*)g.Bt + (size_t)cur.pn * tstep;
    S.a_ready(cur);
    if constexpr (SP2) {
        PG8_STAGE(PG8_SB(0, 0), cB, voffB); PG8_STAGE(PG8_SB(0, 1), cB + hstep, voffB); PG8_STAGE(PG8_SA(0, 0), cA, voffA); PG8_STAGE(PG8_SA(0, 1), cA + hstep, voffA);
        if (wr == 1) PG8_BAR;
        PG8_WAIT_V(2); PG8_BAR;
        PG8_STAGE(PG8_SB(1, 0), cB + kstep, voffB); PG8_STAGE(PG8_SA(1, 0), cA + kstep, voffA); PG8_STAGE(PG8_SB(1, 1), cB + hstep + kstep, voffB);
        PG8_WAIT_V(6); PG8_BAR;
    } else {
        PG8_STAGE(PG8_SB(0, 0), cB, voffB); PG8_STAGE(PG8_SA(0, 0), cA, voffA); PG8_STAGE(PG8_SB(0, 1), cB + hstep, voffB); PG8_STAGE(PG8_SA(0, 1), cA + hstep, voffA);
        if (wr == 1) PG8_BAR;
        PG8_WAIT_V(4); PG8_BAR;
        PG8_STAGE(PG8_SB(1, 0), cB + kstep, voffB); PG8_STAGE(PG8_SA(1, 0), cA + kstep, voffA); PG8_STAGE(PG8_SB(1, 1), cB + hstep + kstep, voffB);
        PG8_WAIT_V(6); PG8_BAR;
    }
    for (;;) {
        const bool has_next = S.next(ui + 1, nxt);
        const char* nA = has_next ? (const char*)g.A + (size_t)nxt.pm * tstep : cA; const char* nB = has_next ? (const char*)g.Bt + (size_t)nxt.pn * tstep : cB;
        for (int t = 0; t < nt; t += 2) {
            const bool last = (t == nt - 2);
            const char* a1 = cA + (size_t)(t + 1) * kstep;
            const char* a2 = last ? nA : cA + (size_t)(t + 2) * kstep; const char* b2 = last ? nB : cB + (size_t)(t + 2) * kstep;
            const char* a3 = a2 + kstep; const char* b3 = b2 + kstep;
            if (last && has_next) S.a_ready(nxt);
            if constexpr (SP2) {
            PG8_LDB(B0, 0, 0); PG8_LDB(B1, 0, 1); PG8_SCHED; PG8_LDA(At, 0, 0); PG8_STAGE(PG8_SA(1, 1), a1 + hstep, voffA);
            PG8_WAIT_V(8); PG8_WAIT_L(0); PG8_BAR; PG8_MMA(0, 0, At, B0); PG8_MMA(0, 1, At, B1); PG8_BAR; PG8_SCHED;
            PG8_LDA(At, 0, 1); PG8_STAGE(PG8_SB(0, 0), b2, voffB); PG8_STAGE(PG8_SB(0, 1), b2 + hstep, voffB); PG8_STAGE(PG8_SA(0, 0), a2, voffA);
            PG8_WAIT_V(8); PG8_WAIT_L(0); PG8_BAR; PG8_MMA(1, 0, At, B0); PG8_MMA(1, 1, At, B1); PG8_BAR; PG8_SCHED;
            PG8_LDB(B0, 1, 0); PG8_LDB(B1, 1, 1); PG8_SCHED; PG8_LDA(At, 1, 0); PG8_STAGE(PG8_SA(0, 1), a2 + hstep, voffA);
            PG8_WAIT_V(8); PG8_WAIT_L(0); PG8_BAR; PG8_MMA(0, 0, At, B0); PG8_MMA(0, 1, At, B1); PG8_BAR; PG8_SCHED;
            PG8_LDA(At, 1, 1); PG8_STAGE(PG8_SB(1, 0), b3, voffB); PG8_STAGE(PG8_SB(1, 1), b3 + hstep, voffB); PG8_STAGE(PG8_SA(1, 0), a3, voffA);
            PG8_WAIT_V(8); PG8_WAIT_L(0); PG8_BAR; PG8_MMA(1, 0, At, B0); PG8_MMA(1, 1, At, B1); PG8_BAR; PG8_SCHED;
            if constexpr (Epi::KHOOK) E.khook(acc, cur, t, nt, wr, fr);
            } else {
            PG8_LDB(B0, 0, 0); PG8_SCHED; PG8_LDA(At, 0, 0); PG8_STAGE(PG8_SA(1, 1), a1 + hstep, voffA);
            PG8_WAIT_L(8); PG8_BAR; PG8_WAIT_L(0); PG8_MMA(0, 0, At, B0); PG8_BAR; PG8_SCHED;
            PG8_LDB(B1, 0, 1); PG8_STAGE(PG8_SB(0, 0), b2, voffB);
            PG8_BAR; PG8_WAIT_L(0); PG8_MMA(0, 1, At, B1); PG8_BAR;
            PG8_LDA(At, 0, 1); PG8_STAGE(PG8_SA(0, 0), a2, voffA);
            PG8_BAR; PG8_WAIT_L(0); PG8_MMA(1, 0, At, B0); PG8_BAR; PG8_SCHED;
            PG8_STAGE(PG8_SB(0, 1), b2 + hstep, voffB);
            PG8_WAIT_V(6); PG8_BAR; PG8_MMA(1, 1, At, B1); PG8_BAR;
            PG8_LDB(B0, 1, 0); PG8_SCHED; PG8_LDA(At, 1, 0); PG8_STAGE(PG8_SA(0, 1), a2 + hstep, voffA);
            PG8_WAIT_L(8); PG8_BAR; PG8_WAIT_L(0); PG8_MMA(0, 0, At, B0); PG8_BAR; PG8_SCHED;
            PG8_LDB(B1, 1, 1); PG8_STAGE(PG8_SB(1, 0), b3, voffB);
            PG8_BAR; PG8_WAIT_L(0); PG8_MMA(0, 1, At, B1); PG8_BAR;
            PG8_LDA(At, 1, 1); PG8_STAGE(PG8_SA(1, 0), a3, voffA);
            PG8_BAR; PG8_WAIT_L(0); PG8_MMA(1, 0, At, B0); PG8_BAR; PG8_SCHED;
            PG8_STAGE(PG8_SB(1, 1), b3 + hstep, voffB);
            PG8_WAIT_V(6); PG8_BAR; PG8_MMA(1, 1, At, B1); PG8_BAR;
            }
        }
        if constexpr (ALIGN_EPI) { if (wr == 0) PG8_BAR; }
        if constexpr (!Epi::AFTER_DRAIN) { E(acc, cur, wr, wc, fr, fq); S.done(cur); }
        if (!has_next) break;
#pragma unroll
        for (int a = 0; a < 2; ++a)
#pragma unroll
            for (int b = 0; b < 2; ++b)
#pragma unroll
                for (int m = 0; m < 4; ++m)
#pragma unroll
                    for (int n = 0; n < 2; ++n) acc[a][b][m][n] = (f32x4){0.f, 0.f, 0.f, 0.f};
        cur = nxt; cA = nA; cB = nB; ++ui;
        if constexpr (ALIGN_EPI) { if (wr == 1) PG8_BAR; }
    }
    PG8_WAIT_V(0);
    if constexpr (!ALIGN_EPI) { if (wr == 0) PG8_BAR; }
    PG8_BAR;
    if constexpr (Epi::AFTER_DRAIN) { E.fused(acc, cur, wr, wc, fr, fq, lds, wid, lane); S.done(cur); }
#undef PG8_SA
#undef PG8_SB
#undef PG8_STAGE
#undef PG8_LDA
#undef PG8_LDB
#undef PG8_MMA
#undef PG8_WAIT_V
#undef PG8_WAIT_L
#undef PG8_BAR
#undef PG8_SCHED
}
}
#ifndef PG8_SP2
#define PG8_SP2 true
#endif
#include <hip/hip_bf16.h>
#include <cmath>
namespace attn_body {
using bf16=__hip_bfloat16;
using bf16x8=__attribute__((ext_vector_type(8)))short;
using s16x4=__attribute__((ext_vector_type(4)))short;
using f32x16=__attribute__((ext_vector_type(16)))float;
using u32x4=__attribute__((ext_vector_type(4)))unsigned;
using f32x4_t=__attribute__((ext_vector_type(4)))float;
constexpr int BATCH=8,NHEAD=16,SEQ=2048,D=64,DM=NHEAD*D;
constexpr int NW=8,QBLK=32,QB=QBLK*NW,KVBLK=64,NQB=SEQ/QB;
constexpr int ATTN_PITCH=DM, ATTN_UNIT_ROWS=QB;
__device__ __forceinline__ int crow(int r,int hi){return (r&3)+8*(r>>2)+4*hi;}
#define SBAR() __builtin_amdgcn_sched_barrier(0)
__device__ __forceinline__ void cmask(f32x16&p0,f32x16&p1,int jb,int qrel,int hi){
  const float NEG=-INFINITY; int kb=64*jb+4*hi;
  #pragma unroll
  for(int r=0;r<16;++r){int kv=kb+(r&3)+8*(r>>2); if(kv>qrel)p0[r]=NEG; if(kv+32>qrel)p1[r]=NEG;}
}

constexpr int NSLOT=3, SLOTB=8192;
constexpr int LDS_K=0, LDS_V=NSLOT*SLOTB, LDS_WS=2*NSLOT*SLOTB, LDS_OST=LDS_WS+NW*64*4, LDS_BIAS=LDS_OST+NW*4096, LDS_BYTES=LDS_BIAS+8192;
constexpr float C2=0.125f*1.4426950408889634f;
__device__ __forceinline__ void glds16(const void*gsrc,unsigned lds_dst){unsigned keep;
  asm volatile("s_mov_b32 %0, m0\n\ts_mov_b32 m0, %2\n\ts_nop 0\n\tglobal_load_lds_dwordx4 %1, off\n\ts_mov_b32 m0, %0":"=&s"(keep):"v"(gsrc),"s"(lds_dst):"memory");}
__device__ __forceinline__ float max3f(float a,float b,float c){float r;asm("v_max3_f32 %0, %1, %2, %3":"=v"(r):"v"(a),"v"(b),"v"(c));return r;}
__device__ __forceinline__ float max2f(float a,float b){float r;asm("v_max_f32_e32 %0, %1, %2":"=v"(r):"v"(a),"v"(b));return r;}
__device__ __forceinline__ float fadd_s(float a,float b){float r;asm("v_add_f32_e32 %0, %1, %2":"=v"(r):"v"(a),"v"(b));return r;}
__device__ __forceinline__ float fsub_s(float a,float b){float r;asm("v_sub_f32_e32 %0, %1, %2":"=v"(r):"v"(a),"v"(b));return r;}
typedef float f32x2_t __attribute__((ext_vector_type(2))); typedef __bf16 bf16x2_t __attribute__((ext_vector_type(2)));
__device__ __forceinline__ unsigned cvtpk_s(float lo,float hi){f32x2_t v={lo,hi};bf16x2_t b=__builtin_convertvector(v,bf16x2_t);return __builtin_bit_cast(unsigned,b);}
#define WAIT_BAR(N) asm volatile("s_waitcnt vmcnt(" #N ") lgkmcnt(0)\n\ts_barrier":::"memory")

__device__ __forceinline__ void qkt(f32x16&p0,f32x16&p1,const char*Kslot,const bf16x8*qr,int r32,int hi){
  const char*kb=Kslot+hi*1024+r32*16;
  #pragma unroll
  for(int d0=0;d0<4;++d0){
    const bf16x8 b0=*reinterpret_cast<const bf16x8*>(kb+d0*2048);
    const bf16x8 b1=*reinterpret_cast<const bf16x8*>(kb+d0*2048+512);
    p0=__builtin_amdgcn_mfma_f32_32x32x16_bf16(b0,qr[d0],p0,0,0,0);p1=__builtin_amdgcn_mfma_f32_32x32x16_bf16(b1,qr[d0],p1,0,0,0);}
}
typedef __attribute__((address_space(3))) const char* lds_cptr;
typedef short v4i16_t __attribute__((ext_vector_type(4)));
__device__ __forceinline__ void kload8(bf16x8*kf,lds_cptr kp){
  kf[0]=*(const __attribute__((address_space(3))) bf16x8*)(kp);      kf[1]=*(const __attribute__((address_space(3))) bf16x8*)(kp+512);
  kf[2]=*(const __attribute__((address_space(3))) bf16x8*)(kp+2048); kf[3]=*(const __attribute__((address_space(3))) bf16x8*)(kp+2560);
  kf[4]=*(const __attribute__((address_space(3))) bf16x8*)(kp+4096); kf[5]=*(const __attribute__((address_space(3))) bf16x8*)(kp+4608);
  kf[6]=*(const __attribute__((address_space(3))) bf16x8*)(kp+6144); kf[7]=*(const __attribute__((address_space(3))) bf16x8*)(kp+6656);
}
__device__ __forceinline__ void kload2(bf16x8*kf,lds_cptr kp,int j){ kf[2*j]=*(const __attribute__((address_space(3))) bf16x8*)(kp+j*2048); kf[2*j+1]=*(const __attribute__((address_space(3))) bf16x8*)(kp+j*2048+512); }
__device__ __forceinline__ s16x4 vtr(lds_cptr p){ return __builtin_bit_cast(s16x4,__builtin_amdgcn_ds_read_tr16_b64_v4i16((__attribute__((address_space(3))) v4i16_t*)p)); }
__device__ __forceinline__ float rowmax(const f32x16&p0,const f32x16&p1){
  float a=max3f(p0[0],p0[1],p1[0]),b=max3f(p0[2],p0[3],p1[1]);a=max3f(a,p1[2],p1[3]);
  #pragma unroll
  for(int r=4;r<16;r+=4){a=max3f(a,p0[r],p0[r+1]);b=max3f(b,p0[r+2],p0[r+3]);a=max3f(a,p1[r],p1[r+1]);b=max3f(b,p1[r+2],p1[r+3]);}
  const float m=max2f(a,b);
  auto rr=__builtin_amdgcn_permlane32_swap(__float_as_uint(m),__float_as_uint(m),false,false);
  return max2f(__uint_as_float(rr[0]),__uint_as_float(rr[1]));
}
__device__ __forceinline__ void pv(f32x16*o,int vb,bf16x8 pa0,bf16x8 pa1,bf16x8 pa2,bf16x8 pa3){
  #pragma unroll
  for(int d0=0;d0<2;++d0){s16x4 lo[4],hi[4];
    #pragma unroll
    for(int ks=0;ks<4;++ks){
      asm volatile("ds_read_b64_tr_b16 %0,%1 offset:%c2":"=&v"(lo[ks]):"v"(vb),"i"(d0*4096+ks*1024):"memory");
      asm volatile("ds_read_b64_tr_b16 %0,%1 offset:%c2":"=&v"(hi[ks]):"v"(vb),"i"(d0*4096+ks*1024+512):"memory");}
    asm volatile("s_waitcnt lgkmcnt(0)":::"memory");SBAR();
    #define PK(k) (bf16x8){lo[k][0],lo[k][1],lo[k][2],lo[k][3],hi[k][0],hi[k][1],hi[k][2],hi[k][3]}
    o[d0]=__builtin_amdgcn_mfma_f32_32x32x16_bf16(pa0,PK(0),o[d0],0,0,0);
    o[d0]=__builtin_amdgcn_mfma_f32_32x32x16_bf16(pa1,PK(1),o[d0],0,0,0);
    o[d0]=__builtin_amdgcn_mfma_f32_32x32x16_bf16(pa2,PK(2),o[d0],0,0,0);
    o[d0]=__builtin_amdgcn_mfma_f32_32x32x16_bf16(pa3,PK(3),o[d0],0,0,0);
    #undef PK
  }
}

#ifndef ATTN_STORE16
#define ATTN_STORE16(p,v) (*(u32x4*)(p)=(v))
#endif
template<int THRL,int VAR> __device__ __forceinline__ void attn_unit(int b,int h,int qb,const bf16*Q,const bf16*__restrict__ K,const bf16*__restrict__ V,bf16*O,const float*__restrict__ F2,bool stage_f,char*shm,const int tid_in,const bool nb){
  const int tid=tid_in,lane=tid&63,r32=lane&31,hi=lane>>5; const int wid=__builtin_amdgcn_readfirstlane(tid>>6);
  const long rowbase=(long)b*SEQ; const int q0=qb*QB;
  const bf16*Qw=Q+(rowbase+q0+wid*QBLK)*DM+h*D;
  const bf16*Kh=K+rowbase*DM+h*D,*Vh=V+rowbase*DM+h*D;
  const unsigned lds0=(unsigned)(uintptr_t)shm;
  float*wsf=(float*)(shm+LDS_WS)+wid*64;
  const bf16*ksrc=Kh+(long)lane*DM+wid*8;
  const bf16*vsrc=Vh+(long)(16*(wid&3)+(lane>>2))*DM+(wid>>2)*32+(lane&3)*8;
  const unsigned kdst=lds0+LDS_K+wid*1024, vdst=lds0+LDS_V+wid*1024;
  #define DMA_K(t,slot) glds16(ksrc+(long)(NT-1-(t))*KVBLK*DM,(unsigned)__builtin_amdgcn_readfirstlane(kdst+(slot)))
  #define DMA_V(t,slot) glds16(vsrc+(long)(NT-1-(t))*KVBLK*DM,(unsigned)__builtin_amdgcn_readfirstlane(vdst+(slot)))
  const int vb0=(int)(lds0+LDS_V)+((lane>>4)&1)*32+(lane&3)*8+(4*hi+((lane&15)>>2))*64;
  const char*Kbase=shm+LDS_K; bf16x8 kf[8];
  const lds_cptr shm3=(lds_cptr)shm; const lds_cptr kp0=shm3+LDS_K+hi*1024+r32*16; const lds_cptr vp0=shm3+LDS_V+((lane>>4)&1)*32+(lane&3)*8+(4*hi+((lane&15)>>2))*64;
  const int NT=(q0+QB)/KVBLK;
  if(stage_f){
    const float*lp=F2+((long)b*SEQ+4*tid)*16+h; float a0=lp[0],a1=lp[16],a2=lp[32],a3=lp[48]; a1+=a0;a2+=a1;a3+=a2;
    float inc=a3; int ln_=lane; asm volatile("":"+v"(ln_));
    #pragma unroll
    for(int o_=1;o_<64;o_<<=1){ const float t_=__int_as_float(__builtin_amdgcn_ds_bpermute(((ln_-o_)&63)<<2,__float_as_int(inc))); if(ln_>=o_)inc+=t_; }
    if(ln_==63)wsf[0]=inc;
    asm volatile("s_waitcnt lgkmcnt(0)\n\ts_barrier":::"memory");
    float base_=0.f; for(int w2=0;w2<wid;++w2)base_+=((const float*)(shm+LDS_WS))[w2*64];
    const float ex_=base_+inc-a3; const float L2E_=1.4426950408889634f;
    *(__attribute__((address_space(3))) f32x4_t*)((__attribute__((address_space(3))) char*)shm3+LDS_BIAS+16*tid)=(f32x4_t){(ex_+a0)*L2E_,(ex_+a1)*L2E_,(ex_+a2)*L2E_,(ex_+a3)*L2E_}; }
  #define LDBIAS(P0,P1,t) do{ if(nb){ P0=f32x16{}; P1=f32x16{}; break; } const lds_cptr bp_=shm3+LDS_BIAS+(NT-1-(t))*256+hi*16; \
    _Pragma("unroll") for(int g_=0;g_<4;++g_){ const f32x4_t x0_=*(const __attribute__((address_space(3))) f32x4_t*)(bp_+g_*32); const f32x4_t x1_=*(const __attribute__((address_space(3))) f32x4_t*)(bp_+128+g_*32); \
      P0[4*g_]=x0_[0];P0[4*g_+1]=x0_[1];P0[4*g_+2]=x0_[2];P0[4*g_+3]=x0_[3]; P1[4*g_]=x1_[0];P1[4*g_+1]=x1_[1];P1[4*g_+2]=x1_[2];P1[4*g_+3]=x1_[3]; } }while(0)
  DMA_K(0,0);DMA_V(0,0);DMA_K(1,SLOTB);
  bf16x8 qr[4];
  #pragma unroll
  for(int d0=0;d0<4;++d0)qr[d0]=*reinterpret_cast<const bf16x8*>(&Qw[(long)r32*DM+d0*16+hi*8]);
  float mhat=0.f,l_reg=0.f;f32x16 o[2];o[0]=f32x16{};o[1]=f32x16{};
  const int qrel=wid*QBLK+r32;
  #define CMASK(P0,P1,t) do{int jb_=3-(t); if(jb_>=0)cmask(P0,P1,jb_,qrel,hi);}while(0)
  bool resc=false;
  #define START(P0,P1) do{ const float rm=rowmax(P0,P1); resc=false; \
    { const float dl=(rm<-1e30f)?0.f:rm; mhat=fadd_s(mhat,dl);     \
      _Pragma("unroll") for(int r=0;r<16;++r){P0[r]=fsub_s(P0[r],dl);P1[r]=fsub_s(P1[r],dl);} } \
    _Pragma("unroll") for(int r=0;r<16;++r)P0[r]=__builtin_amdgcn_exp2f(P0[r]); }while(0)
  #define RESC() do{ if(resc){ asm volatile("s_waitcnt lgkmcnt(0)":::"memory"); \
      _Pragma("unroll") for(int d_=0;d_<2;++d_) _Pragma("unroll") for(int r=0;r<16;++r)o[d_][r]*=wsf[crow(r,hi)]; } }while(0)
  f32x16 pA0,pA1,pB0,pB1;
  int sl_prev=0,sl_cur=0,sl_next=SLOTB;
  #define ROT() do{sl_prev=sl_cur;sl_cur=sl_next;sl_next=(sl_next==(NSLOT-1)*SLOTB)?0:sl_next+SLOTB;}while(0)
  DMA_K(2,2*SLOTB);
  WAIT_BAR(3);
  const float fql=*(const __attribute__((address_space(3))) float*)(shm3+LDS_BIAS+4*(q0+wid*QBLK+r32));
  LDBIAS(pA0,pA1,0);
  _Pragma("unroll") for(int r=0;r<16;++r){pA0[r]=fql-pA0[r];pA1[r]=fql-pA1[r];}
  qkt(pA0,pA1,Kbase,qr,r32,hi);asm volatile("s_nop 15\n\ts_nop 7":"+v"(pA0),"+v"(pA1));CMASK(pA0,pA1,0);
  START(pA0,pA1);
  _Pragma("unroll") for(int r=0;r<16;++r)pA1[r]=__builtin_amdgcn_exp2f(pA1[r]);
  WAIT_BAR(0);
  DMA_K(3,0);DMA_V(1,SLOTB);
  ROT();
  kload8(kf,kp0+sl_cur);
  WAIT_BAR(2);
  s16x4 vlo[8],vhi[8]; u32x4 pw0,pw1,pw2,pw3;
  #define PKW(P,B) cvtpk_s(P[B],P[B+1])
  #define PAF(k) __builtin_bit_cast(bf16x8,pw##k)
  #define VFR(i) (bf16x8){vlo[i][0],vlo[i][1],vlo[i][2],vlo[i][3],vhi[i][0],vhi[i][1],vhi[i][2],vhi[i][3]}
  #define PIN(x) asm volatile("":"+v"(x))
  #define MX3(a,b,c) __builtin_fmaxf(__builtin_fmaxf((a),(b)),(c))
  #define GAPA(MF,MD,A0,A1,A2,A3,W0,W1,PW) do{ MF; PIN(MD); sacc+=A0; sacc+=A1; sacc+=A2; sacc+=A3; PIN(sacc); W0; W1; PIN(PW); SBAR(); }while(0)
  #define EX(v) __builtin_amdgcn_exp2f(v)
  #define GAPB(MF,X,B) do{ MF; X[B]=EX(X[B]); X[B+1]=EX(X[B+1]); X[B+2]=EX(X[B+2]); X[B+3]=EX(X[B+3]); PIN(X); SBAR(); }while(0)
  #define VRD(i) do{ vlo[i]=vtr(vp_+(((i)>>2)*4096+((i)&3)*1024)); vhi[i]=vtr(vp_+(((i)>>2)*4096+((i)&3)*1024+512)); }while(0)
  #define KRD(G,j) do{ if(G){ kload2(kf,kp0+sl_next,j); SBAR(); } }while(0)
  #define STEP(C0,C1,P0,P1,t,GK,GV,GL) do{ SBAR(); \
    const float fm_=fql-mhat; const f32x2_t fm2_={fm_,fm_}; _Pragma("unroll") for(int r=0;r<16;r+=2){ f32x2_t v_={C0[r],C0[r+1]}; v_=fm2_-v_; C0[r]=v_[0]; C0[r+1]=v_[1]; } \
    const lds_cptr vp_=vp0+sl_prev; \
    VRD(0); SBAR(); float sacc=(P0[0]+P0[1]); \
    GAPA(C0=__builtin_amdgcn_mfma_f32_32x32x16_bf16(kf[0],qr[0],C0,0,0,0),C0, P0[2],P0[3],P0[4],P0[5],     pw0[0]=PKW(P0,0), pw0[1]=PKW(P0,2), pw0); \
    _Pragma("unroll") for(int r=0;r<16;r+=2){ f32x2_t v_={C1[r],C1[r+1]}; v_=fm2_-v_; C1[r]=v_[0]; C1[r+1]=v_[1]; } PIN(C1); SBAR(); \
    VRD(4); SBAR(); GAPA(C1=__builtin_amdgcn_mfma_f32_32x32x16_bf16(kf[1],qr[0],C1,0,0,0),C1, P0[6],P0[7],P0[8],P0[9],     pw0[2]=PKW(P0,4), pw0[3]=PKW(P0,6), pw0); \
    VRD(1); SBAR(); GAPA(C0=__builtin_amdgcn_mfma_f32_32x32x16_bf16(kf[2],qr[1],C0,0,0,0),C0,   P0[10],P0[11],P0[12],P0[13], pw1[0]=PKW(P0,8), pw1[1]=PKW(P0,10), pw1); \
    VRD(5); SBAR(); GAPA(C1=__builtin_amdgcn_mfma_f32_32x32x16_bf16(kf[3],qr[1],C1,0,0,0),C1,   P0[14],P0[15],P1[0],P1[1],   pw1[2]=PKW(P0,12),pw1[3]=PKW(P0,14), pw1); \
    VRD(2); SBAR(); GAPA(C0=__builtin_amdgcn_mfma_f32_32x32x16_bf16(kf[4],qr[2],C0,0,0,0),C0,   P1[2],P1[3],P1[4],P1[5],     pw2[0]=PKW(P1,0), pw2[1]=PKW(P1,2), pw2); \
    VRD(6); SBAR(); GAPA(C1=__builtin_amdgcn_mfma_f32_32x32x16_bf16(kf[5],qr[2],C1,0,0,0),C1,   P1[6],P1[7],P1[8],P1[9],     pw2[2]=PKW(P1,4), pw2[3]=PKW(P1,6), pw2); \
    VRD(3); SBAR(); GAPA(C0=__builtin_amdgcn_mfma_f32_32x32x16_bf16(kf[6],qr[3],C0,0,0,0),C0,   P1[10],P1[11],P1[12],P1[13], pw3[0]=PKW(P1,8), pw3[1]=PKW(P1,10), pw3); \
    VRD(7); SBAR(); GAPA(C1=__builtin_amdgcn_mfma_f32_32x32x16_bf16(kf[7],qr[3],C1,0,0,0),C1,   P1[14],P1[15],0.f,0.f,       pw3[2]=PKW(P1,12),pw3[3]=PKW(P1,14), pw3); \
    l_reg+=sacc; if(GV){LDBIAS(P0,P1,(t)+1);} \
    if(GK){DMA_K((t)+3,sl_cur);} if(GV){DMA_V((t)+1,sl_next);} \
    CMASK(C0,C1,t); \
    { float a=MX3(C0[0],C0[1],C1[0]),b=MX3(C0[2],C0[3],C1[1]); a=MX3(a,C1[2],C1[3]); \
      _Pragma("unroll") for(int r=4;r<16;r+=4){a=MX3(a,C0[r],C0[r+1]);b=MX3(b,C0[r+2],C0[r+3]);a=MX3(a,C1[r],C1[r+1]);b=MX3(b,C1[r+2],C1[r+3]);} \
      float rm=__builtin_fmaxf(a,b); { auto rr=__builtin_amdgcn_permlane32_swap(__float_as_uint(rm),__float_as_uint(rm),false,false); rm=__builtin_fmaxf(__uint_as_float(rr[0]),__uint_as_float(rr[1])); } \
      resc=false; \
      if(__builtin_expect(__any(rm>(float)THRL),0)){ const float dl=__builtin_fmaxf(rm,0.f); mhat+=dl; \
        _Pragma("unroll") for(int r=0;r<16;++r){C0[r]-=dl;C1[r]-=dl;} \
        const float f=__builtin_amdgcn_exp2f(-dl); l_reg*=f; if(hi==0)wsf[r32]=f; resc=true; } } \
    SBAR(); \
    GAPB(o[0]=__builtin_amdgcn_mfma_f32_32x32x16_bf16(PAF(0),VFR(0),o[0],0,0,0), C0,0); \
    GAPB(o[1]=__builtin_amdgcn_mfma_f32_32x32x16_bf16(PAF(0),VFR(4),o[1],0,0,0), C0,4); \
    KRD(GL,0); GAPB(o[0]=__builtin_amdgcn_mfma_f32_32x32x16_bf16(PAF(1),VFR(1),o[0],0,0,0), C0,8); \
    KRD(GL,1); GAPB(o[1]=__builtin_amdgcn_mfma_f32_32x32x16_bf16(PAF(1),VFR(5),o[1],0,0,0), C0,12); \
    KRD(GL,2); GAPB(o[0]=__builtin_amdgcn_mfma_f32_32x32x16_bf16(PAF(2),VFR(2),o[0],0,0,0), C1,0); \
    KRD(GL,3); GAPB(o[1]=__builtin_amdgcn_mfma_f32_32x32x16_bf16(PAF(2),VFR(6),o[1],0,0,0), C1,4); \
    GAPB(o[0]=__builtin_amdgcn_mfma_f32_32x32x16_bf16(PAF(3),VFR(3),o[0],0,0,0), C1,8); \
    GAPB(o[1]=__builtin_amdgcn_mfma_f32_32x32x16_bf16(PAF(3),VFR(7),o[1],0,0,0), C1,12); \
    }while(0)
  LDBIAS(pB0,pB1,1);
  int t=1;
  #define ENDW(tt) do{ if((tt)+3<NT){WAIT_BAR(2);} else if((tt)+2<NT){WAIT_BAR(1);} else {WAIT_BAR(0);} }while(0)
  for(;t<5&&t+1<NT;t+=2){
    STEP(pB0,pB1,pA0,pA1,t,(t+3<NT),(t+1<NT),(t+1<NT));       ENDW(t);   RESC(); ROT();
    STEP(pA0,pA1,pB0,pB1,t+1,(t+4<NT),(t+2<NT),(t+2<NT));     ENDW(t+1); RESC(); ROT();
  }
  #undef CMASK
  #define CMASK(P0,P1,t) do{}while(0)
  for(;t+5<NT;t+=2){
    STEP(pB0,pB1,pA0,pA1,t,true,true,true);     WAIT_BAR(2); RESC(); ROT();
    STEP(pA0,pA1,pB0,pB1,t+1,true,true,true);   WAIT_BAR(2); RESC(); ROT();
  }
  for(;t+1<NT;t+=2){
    STEP(pB0,pB1,pA0,pA1,t,(t+3<NT),(t+1<NT),(t+1<NT));       ENDW(t);   RESC(); ROT();
    STEP(pA0,pA1,pB0,pB1,t+1,(t+4<NT),(t+2<NT),(t+2<NT));     ENDW(t+1); RESC(); ROT();
  }
  #undef CMASK
  #define CMASK(P0,P1,t) do{int jb_=3-(t); if(jb_>=0)cmask(P0,P1,jb_,qrel,hi);}while(0)
  STEP(pB0,pB1,pA0,pA1,NT-1,false,false,false); RESC();
  { float sacc=pB0[0]+pB0[1]; _Pragma("unroll") for(int r=2;r<16;++r)sacc+=pB0[r]; _Pragma("unroll") for(int r=0;r<16;++r)sacc+=pB1[r]; l_reg+=sacc;
    pw0=(u32x4){PKW(pB0,0),PKW(pB0,2),PKW(pB0,4),PKW(pB0,6)};pw1=(u32x4){PKW(pB0,8),PKW(pB0,10),PKW(pB0,12),PKW(pB0,14)};pw2=(u32x4){PKW(pB1,0),PKW(pB1,2),PKW(pB1,4),PKW(pB1,6)};pw3=(u32x4){PKW(pB1,8),PKW(pB1,10),PKW(pB1,12),PKW(pB1,14)};
    SBAR(); pv(o,vb0+sl_cur,PAF(0),PAF(1),PAF(2),PAF(3)); }
  #undef PKW
  #undef PAF
  #undef VFR
  #undef PIN
  #undef MX3
  #undef GAPA
  #undef GAPB
  #undef EX
  #undef VRD
  #undef KRD
  #undef STEP
  #undef ENDW
  {auto rr=__builtin_amdgcn_permlane32_swap(__float_as_uint(l_reg),__float_as_uint(l_reg),false,false);l_reg=__uint_as_float(rr[0])+__uint_as_float(rr[1]);}
  if(hi==0)wsf[32+r32]=l_reg;asm volatile("s_waitcnt lgkmcnt(0)":::"memory");
  float rli[16];
  #pragma unroll
  for(int r=0;r<16;++r)rli[r]=__builtin_amdgcn_rcpf(wsf[32+crow(r,hi)]);
  bf16*Ow=O+(rowbase+q0+wid*QBLK)*DM+h*D;
  { bf16*stg=(bf16*)(shm+LDS_OST)+wid*2048;
    #pragma unroll
    for(int r=0;r<16;++r){const int orow=crow(r,hi);
      #pragma unroll
      for(int d0=0;d0<2;++d0)stg[orow*64+d0*32+r32]=__float2bfloat16(o[d0][r]*rli[r]);}
    asm volatile("s_waitcnt lgkmcnt(0)":::"memory");
    #pragma unroll
    for(int i=0;i<4;++i){const int row=i*8+(lane>>3),ch=lane&7; const u32x4 v=*(const u32x4*)(stg+row*64+ch*8); ATTN_STORE16(Ow+(long)row*DM+ch*8,v);} }
  asm volatile("s_waitcnt lgkmcnt(0)\n\ts_barrier":::"memory");
  #undef DMA_K
  #undef DMA_V
  #undef CMASK
  #undef START
  #undef RESC
  #undef ROT
  #undef LDBIAS
}
constexpr int ATTN_LDS_BYTES=LDS_BYTES;
struct AttnTensors { const bf16* Q; const bf16* K; const bf16* V; bf16* O; const float* F2; };
struct AttnUnit { int bh; int qb; };
struct StaticOrder {
  int vcu,G,fqb;
  __device__ __forceinline__ explicit StaticOrder(int grid,int v,int f=-1):vcu(v),G(grid),fqb(f){}
  __device__ __forceinline__ bool next(int i,AttnUnit&u)const{
    if(G==256){ if(i>=4)return false; const int s=vcu&3; u.bh=(i>>1)*64+(vcu>>2); u.qb=(i&1)?7-s:s; if(fqb>=0)u.qb=fqb; return true; }
    const int L=i*G+vcu; if(L>=BATCH*NHEAD*NQB)return false; u.bh=L/NQB; u.qb=NQB-1-(L%NQB); return true; }
  __device__ __forceinline__ void a_ready(const AttnUnit&)const{}
  __device__ __forceinline__ void done(const AttnUnit&)const{}
};
template<class Sched,int VAR=0,int THRL=8> __device__ __forceinline__ void attn_phase(char*lds,const AttnTensors&T,const Sched&S,const int tid_in,const bool nb=false){
  AttnUnit u; int last_bh=-1;
  for(int i=0;S.next(i,u);++i){ S.a_ready(u); attn_unit<THRL,VAR>(u.bh/NHEAD,u.bh%NHEAD,u.qb,T.Q,T.K,T.V,T.O,T.F2,u.bh!=last_bh,lds,tid_in,nb); last_bh=u.bh; S.done(u); }
}
#undef SBAR
#undef WAIT_BAR
}
constexpr int NWAVES = 8;
constexpr int BATCH = 8, SEQ = 2048, D = 1024, FF = 4096, DEPTH = 4, NA = 2;
constexpr int M = BATCH * SEQ;
constexpr int A_PROJ = 3080, KV_PROJ = 2064;
constexpr float EPS = 1e-6f;
constexpr float LOG2E = 1.4426950408889634f;
constexpr size_t MiB = 1u << 20;
constexpr size_t WS_BAR = 0, WS_BAR_BYTES = 16384;
constexpr size_t WS_MOD = 1 * MiB, WS_F2 = 2 * MiB, WS_IG = 3 * MiB, WS_LF = 3 * MiB + 512 * 1024, WS_LF16 = 4 * MiB;
constexpr size_t WS_WIN = 6 * MiB, WS_WAO = 18 * MiB, WS_WKV = 22 * MiB, WS_WQ = 26 * MiB, WS_WBO = 30 * MiB, WS_W1 = 34 * MiB, WS_W2 = 66 * MiB;
constexpr size_t WS_XN = 98 * MiB, WS_KF = 130 * MiB, WS_VF = 162 * MiB, WS_OV = 194 * MiB, WS_KVN = 322 * MiB, WS_SS = 354 * MiB, WS_SHW = 355 * MiB, WS_HS = 356 * MiB, WS_END = 357 * MiB;
constexpr size_t WS_PTR = 5 * MiB + 512 * 1024;
constexpr size_t WS_PAR = 5 * MiB;
constexpr int PG_IN = 0, PG_KV = 16384, PBI = 32768, PBF = 32776, PHG = 32784, PKVG = 34832, PFGB = 35856, PFG = 35872, PAR_N = 36896;
constexpr size_t WS_H = WS_OV, WS_QA = WS_OV, WS_KA = WS_OV + 16 * MiB, WS_VA = WS_OV + 32 * MiB, WS_OA = WS_OV + 64 * MiB, WS_HT = WS_OV + 96 * MiB;
constexpr size_t WS_QO = WS_OV, WS_G = WS_OV;
constexpr int SHW_IN = 0, SHW_UP = 2 * 8 * A_PROJ, SHW_Q = SHW_UP + 4 * 8 * 4096;
constexpr int RING_BYTES = 131072, LDS_BYTES = 147456, MISC_OFF = LDS_BYTES - 256;
constexpr int NPH = 3 + 6 * DEPTH;

#define GAS __attribute__((address_space(1)))
#define LAS __attribute__((address_space(3)))
typedef unsigned short bf16;
typedef unsigned v4u __attribute__((ext_vector_type(4)));
typedef unsigned v2u __attribute__((ext_vector_type(2)));
typedef float f32x4 __attribute__((ext_vector_type(4)));
typedef short bf16x8 __attribute__((ext_vector_type(8)));
#define LDS_WAIT() asm volatile("s_waitcnt lgkmcnt(0)" ::: "memory")
typedef float f32x2h_t __attribute__((ext_vector_type(2))); typedef __bf16 bf16x2h_t __attribute__((ext_vector_type(2)));
__device__ __forceinline__ unsigned pk2(float lo, float hi) { const f32x2h_t v = {lo, hi}; return __builtin_bit_cast(unsigned, __builtin_convertvector(v, bf16x2h_t)); }
__device__ __forceinline__ unsigned f2bf(float f) { return pk2(f, 0.f) & 0xffffu; }
__device__ __forceinline__ float bflo(unsigned w) { return __uint_as_float(w << 16); }
__device__ __forceinline__ float bfhi(unsigned w) { return __uint_as_float(w & 0xffff0000u); }
__device__ __forceinline__ float bf1(unsigned short b) { return __uint_as_float((unsigned)b << 16); }
__device__ __forceinline__ float shfl_i(float v, int src_lane) { return __int_as_float(__builtin_amdgcn_ds_bpermute(src_lane << 2, __float_as_int(v))); }
__device__ __forceinline__ float wave_sum(float v, int lane) {
#pragma unroll
    for (int o = 1; o < 64; o <<= 1) v += shfl_i(v, lane ^ o);
    return v;
}
__device__ __forceinline__ float logsigmoidf_(float x) { return fminf(x, 0.f) - __logf(1.0f + __expf(-fabsf(x))); }

#define RLX_AGENT __ATOMIC_RELAXED, __HIP_MEMORY_SCOPE_AGENT
#define XB_TMO      128
#define XB_XCNT(j)  (256  + 64 * (j))
#define XB_XSUB(j)  (1280 + 64 * (j))
#define XB_XGEN(j)  (2304 + 64 * (j))
#define XB_TOP      3328
#define XB_TOPGEN   3392
#define XCD_BAR_WORDS 3456
#define XB_SPIN_CAP (1u << 18)

__device__ __forceinline__ unsigned xb_ld(unsigned* p)              { return __hip_atomic_load(p, __ATOMIC_RELAXED, __HIP_MEMORY_SCOPE_AGENT); }
__device__ __forceinline__ unsigned xb_add(unsigned* p, unsigned v) { return __hip_atomic_fetch_add(p, v, __ATOMIC_RELAXED, __HIP_MEMORY_SCOPE_AGENT); }
__device__ __forceinline__ unsigned xb_xcc_id() { return (unsigned)__builtin_amdgcn_s_getreg((3 << 11) | 20) & 0xFu; }
#define XB_SPIN(cond, bar) do { unsigned _sp = 0; while (cond) { __builtin_amdgcn_s_sleep(1); \
    if ((++_sp & 255u) == 0u) { if (xb_ld(&(bar)[XB_TMO])) break; if (_sp > XB_SPIN_CAP) { atomicAdd(&(bar)[XB_TMO], 1u); break; } } } } while (0)

struct XcdBarrier {
    unsigned* bar; unsigned x;
    volatile LAS unsigned* st;
};

__device__ __forceinline__ XcdBarrier xcd_barrier_post(unsigned* bar, volatile LAS unsigned* st, int tid_) {
    XcdBarrier b; b.bar = bar; b.x = xb_xcc_id(); b.st = st;
    if (tid_ == 0) (void)xb_add(&bar[XB_XCNT(b.x)], 1u);
    return b;
}
__device__ __forceinline__ void xcd_barrier_complete(unsigned* bar, unsigned x, unsigned& nloc, unsigned& nx) {
    const unsigned G = gridDim.x * gridDim.y * gridDim.z;
    unsigned sum, cnt, mine, sp = 0u;
    for (;;) {
        sum = 0u; cnt = 0u; mine = 0u;
#pragma unroll
        for (unsigned j = 0; j < 16; ++j) { const unsigned c = xb_ld(&bar[XB_XCNT(j)]); sum += c; cnt += (c > 0u) ? 1u : 0u; mine = (j == x) ? c : mine; }
        if (sum == G) break;
        __builtin_amdgcn_s_sleep(1);
        if ((++sp & 255u) == 0u) { if (xb_ld(&bar[XB_TMO])) break; if (sp > XB_SPIN_CAP) { atomicAdd(&bar[XB_TMO], 1u); break; } }
    }
    nloc = mine > 0u ? mine : 1u; nx = cnt > 0u ? cnt : 1u;
}

__device__ __forceinline__ void xcd_barrier(const XcdBarrier& b, int tid_) {
    asm volatile("s_waitcnt vmcnt(0)" ::: "memory");
    __syncthreads();
    if (tid_ == 0) {
        unsigned* bar = b.bar;
        __builtin_amdgcn_s_waitcnt(0);
        unsigned nloc = b.st[0], nx = b.st[1];
        if (nloc == 0u) { xcd_barrier_complete(bar, b.x, nloc, nx); b.st[0] = nloc; b.st[1] = nx; }
        const unsigned old = xb_add(&bar[XB_XSUB(b.x)], 1u);
        const unsigned gen = old / nloc;
        if (old + 1u == (gen + 1u) * nloc) {
            __builtin_amdgcn_fence(__ATOMIC_RELEASE, "agent");
            asm volatile("s_waitcnt vmcnt(0)" ::: "memory");
            const unsigned og = xb_add(&bar[XB_TOP], 1u);
            const unsigned tg = og / nx;
            if (og + 1u == (tg + 1u) * nx) xb_add(&bar[XB_TOPGEN], 1u);
            else XB_SPIN(xb_ld(&bar[XB_TOPGEN]) == tg, bar);
            __builtin_amdgcn_fence(__ATOMIC_ACQUIRE, "agent");
            xb_add(&bar[XB_XGEN(b.x)], 1u);
            asm volatile("s_waitcnt vmcnt(0)" ::: "memory");
        } else {
            XB_SPIN(xb_ld(&bar[XB_XGEN(b.x)]) == gen, bar);
            __builtin_amdgcn_fence(__ATOMIC_ACQUIRE, "agent");
            asm volatile("s_waitcnt vmcnt(0)" ::: "memory");
        }
    }
    __syncthreads();
}

struct Args { const float* in[17]; float* out; unsigned char* ws; int ph_lo, ph_hi; };
enum { I_X = 0, I_C, I_ADAW, I_ADAB, I_AWIN, I_ABI, I_ABF, I_AHG, I_AWOUT, I_KVG, I_WKV, I_FGB, I_WQ, I_WBO, I_W1, I_W2, I_FG };

struct Frame {
    LAS unsigned char* lds;
    int tid, lane, wave, vcu, G, bx;
    float* X; unsigned char* ws;
};

__device__ __forceinline__ void p0_transpose_item(const float* W, int K, int ldw, int N, bf16* WT, LAS float* scr, int item, int lane) {
    const int nblk = N / 32, kb = item / nblk, nb = item % nblk, k0 = 64 * kb, n0 = 32 * nb;
    { f32x4 v[8];
#pragma unroll
      for (int i = 0; i < 8; ++i) v[i] = *(const f32x4*)(W + (size_t)(k0 + (lane >> 3) + 8 * i) * ldw + n0 + (lane & 7) * 4);
#pragma unroll
      for (int i = 0; i < 8; ++i) { LAS float* d = scr + ((lane >> 3) + 8 * i) * 33 + (lane & 7) * 4; d[0] = v[i].x; d[1] = v[i].y; d[2] = v[i].z; d[3] = v[i].w; } }
    LDS_WAIT(); asm volatile("" ::: "memory");
    const int c = lane & 7;
#pragma unroll
    for (int j = 0; j < 4; ++j) { const int n = (lane >> 3) + 8 * j; const LAS float* s = scr + (8 * c) * 33 + n;
        v4u o; o.x = pk2(s[0 * 33], s[1 * 33]); o.y = pk2(s[2 * 33], s[3 * 33]); o.z = pk2(s[4 * 33], s[5 * 33]); o.w = pk2(s[6 * 33], s[7 * 33]);
        *(v4u*)(WT + (size_t)(n0 + n) * K + k0 + 8 * c) = o; }
    LDS_WAIT(); asm volatile("" ::: "memory");
}
__device__ __forceinline__ void gemv8_item(Frame& F, const float* vec, int vs, bool silu, const float* W, int ld, int ncols, float* out, int os, const float* bias, const bool nt = false) {
    LAS float* cond = (LAS float*)F.lds; LAS float* red = cond + 8192;
    for (int i = F.tid; i < 8192; i += 512) { const float c = vec[(size_t)(i >> 10) * vs + (i & 1023)]; cond[i] = silu ? c / (1.0f + __expf(-c)) : c; }
    __syncthreads();
    const int c4 = F.tid & 31, ks = F.tid >> 5;
    if (c4 * 4 < ncols) {
        f32x4 acc[8];
#pragma unroll
        for (int b = 0; b < 8; ++b) acc[b] = (f32x4){0.f, 0.f, 0.f, 0.f};
#pragma unroll 16
        for (int k = ks; k < 1024; k += 16) { const f32x4* wp = (const f32x4*)(W + (size_t)k * ld + c4 * 4); const f32x4 w = nt ? __builtin_nontemporal_load(wp) : *wp;
#pragma unroll
            for (int b = 0; b < 8; ++b) acc[b] = acc[b] + w * cond[b * 1024 + k]; }
#pragma unroll
        for (int b = 0; b < 8; ++b) *(LAS f32x4*)(red + (ks * 8 + b) * 128 + c4 * 4) = acc[b];
    }
    __syncthreads();
    for (int o = F.tid; o < 1024; o += 512) { const int b = o >> 7, n = o & 127;
        if (n < ncols) { float s = 0.f;
#pragma unroll
            for (int k2 = 0; k2 < 16; ++k2) s += red[(k2 * 8 + b) * 128 + n];
            out[(size_t)b * os + n] = s + (bias ? bias[n] : 0.f); } }
    __syncthreads();
}
__device__ __forceinline__ void p0_prologue(Frame& F, const Args& args) {
    const int gw = F.vcu * NWAVES + F.wave, NGW = F.G * NWAVES;
    { f32x4* z = (f32x4*)(F.ws + WS_SS) + M / 4; for (int i = F.bx * 512 + F.tid; i < 8 * M / 4; i += F.G * 512) z[i] = (f32x4){0.f, 0.f, 0.f, 0.f};
      f32x4* zh = (f32x4*)(F.ws + WS_HS); for (int i = F.bx * 512 + F.tid; i < 2 * M; i += F.G * 512) zh[i] = (f32x4){0.f, 0.f, 0.f, 0.f}; }
    { float* P = (float*)(F.ws + WS_PAR);
      for (int i = F.bx * 512 + F.tid; i < PAR_N; i += F.G * 512) { float v;
          if (i < PG_KV) { const int l = i >> 13, g = (i >> 10) & 7, k = i & 1023; v = args.in[I_AWIN][(size_t)l * 1024 * A_PROJ + (size_t)k * A_PROJ + 3072 + g]; }
          else if (i < PBI) { const int g = (i - PG_KV) >> 10, k = i & 1023; v = args.in[I_WKV][(size_t)k * KV_PROJ + 2048 + g]; }
          else if (i < PBF) v = args.in[I_ABI][i - PBI];
          else if (i < PHG) v = args.in[I_ABF][i - PBF];
          else if (i < PKVG) v = args.in[I_AHG][i - PHG];
          else if (i < PFGB) v = args.in[I_KVG][i - PKVG];
          else if (i < PFG) v = args.in[I_FGB][i - PFGB];
          else v = args.in[I_FG][i - PFG];
          P[i] = v; } }
#ifndef REP_ADA
#define REP_ADA 1
#endif
    for (int rp_ = 0; rp_ < REP_ADA; ++rp_)
    for (int it = F.vcu; it < 256; it += F.G) { const int l = it >> 6, n0 = (it & 63) * 96;
        gemv8_item(F, args.in[I_C], 1024, true, args.in[I_ADAW] + (size_t)l * 1024 * 6144 + n0, 6144, 96, (float*)(F.ws + WS_MOD) + (size_t)l * 8 * 6144 + n0, 6144, args.in[I_ADAB] + l * 6144 + n0, true); }
    LAS float* scr = (LAS float*)(F.lds + F.wave * 16384);
    constexpr int NITEMS = 23552;
#ifndef REP_TR
#define REP_TR 1
#endif
    for (int rp_ = 0; rp_ < REP_TR; ++rp_)
    for (int it = gw; it < NITEMS; it += NGW) {
        int r = it; const float* src; bf16* dst; int K = 1024, ld = 1024, N = 1024;
        if (r < 3072) { const int l = r / 1536; r %= 1536; src = args.in[I_AWIN] + (size_t)l * 1024 * A_PROJ; ld = A_PROJ; N = 3072; dst = (bf16*)(F.ws + WS_WIN) + (size_t)l * 3072 * 1024; }
        else if ((r -= 3072) < 1024) { const int l = r / 512; r %= 512; src = args.in[I_AWOUT] + (size_t)l * 1024 * 1024; dst = (bf16*)(F.ws + WS_WAO) + (size_t)l * 1024 * 1024; }
        else if ((r -= 1024) < 1024) { src = args.in[I_WKV]; ld = KV_PROJ; N = 2048; dst = (bf16*)(F.ws + WS_WKV); }
        else if ((r -= 1024) < 1024) { const int l = r / 512; r %= 512; src = args.in[I_WQ] + (size_t)l * 1024 * 1024; dst = (bf16*)(F.ws + WS_WQ) + (size_t)l * 1024 * 1024; }
        else if ((r -= 1024) < 1024) { const int l = r / 512; r %= 512; src = args.in[I_WBO] + (size_t)l * 1024 * 1024; dst = (bf16*)(F.ws + WS_WBO) + (size_t)l * 1024 * 1024; }
        else if ((r -= 1024) < 8192) { const int l = r / 2048; r %= 2048; src = args.in[I_W1] + (size_t)l * 1024 * 4096; ld = 4096; N = 4096; dst = (bf16*)(F.ws + WS_W1) + (size_t)l * 1024 * 4096; }
        else { r -= 8192; const int l = r / 2048; r %= 2048; src = args.in[I_W2] + (size_t)l * 1024 * 4096; K = 4096; dst = (bf16*)(F.ws + WS_W2) + (size_t)l * 1024 * 4096; }
        p0_transpose_item(src, K, ld, N, dst, scr, r, F.lane);
    }
}
__device__ __forceinline__ void p1_prologue(Frame& F, const Args& args) {
    const int gw = F.vcu * NWAVES + F.wave, NGW = F.G * NWAVES;
    const float* MOD = (const float*)(F.ws + WS_MOD); float* SHW = (float*)(F.ws + WS_SHW);
#ifndef REP_SHW
#define REP_SHW 1
#endif
    for (int rp_ = 0; rp_ < REP_SHW; ++rp_)
    for (int it = F.vcu; it < 248; it += F.G) {
        if (it < 62) { const int l = it / 31, n0 = (it % 31) * 100;
            gemv8_item(F, MOD + (size_t)l * 8 * 6144, 6144, false, args.in[I_AWIN] + (size_t)l * 1024 * A_PROJ + n0, A_PROJ, (n0 + 100 <= A_PROJ) ? 100 : A_PROJ - n0, SHW + SHW_IN + (size_t)l * 8 * A_PROJ + n0, A_PROJ, nullptr); }
        else if (it < 226) { const int r = it - 62, l = r / 41, n0 = (r % 41) * 100;
            gemv8_item(F, MOD + (size_t)l * 8 * 6144 + 3072, 6144, false, args.in[I_W1] + (size_t)l * 1024 * 4096 + n0, 4096, (n0 + 100 <= 4096) ? 100 : 4096 - n0, SHW + SHW_UP + (size_t)l * 8 * 4096 + n0, 4096, nullptr); }
        else { const int r = it - 226, j = r / 11, n0 = (r % 11) * 100;
            gemv8_item(F, MOD + (size_t)(NA + j) * 8 * 6144, 6144, false, args.in[I_WQ] + (size_t)j * 1024 * 1024 + n0, 1024, (n0 + 100 <= 1024) ? 100 : 1024 - n0, SHW + SHW_Q + (size_t)j * 8 * 1024 + n0, 1024, nullptr); }
    }
    bf16* XN = (bf16*)(F.ws + WS_XN); float* SS0 = (float*)(F.ws + WS_SS);
    for (int m = gw; m < M; m += 2 * NGW) {
        const int m2 = (m + NGW < M) ? m + NGW : m;
        const f32x4* xa = (const f32x4*)(args.in[I_X] + (size_t)m * D) + F.lane; const f32x4* xb = (const f32x4*)(args.in[I_X] + (size_t)m2 * D) + F.lane;
        f32x4 va[4], vb[4];
#pragma unroll
        for (int j = 0; j < 4; ++j) { va[j] = xa[64 * j]; vb[j] = xb[64 * j]; }
        const float* sca = MOD + (size_t)(m >> 11) * 6144 + 1024; const float* scb = MOD + (size_t)(m2 >> 11) * 6144 + 1024;
        v2u* oa = (v2u*)(XN + (size_t)m * D) + F.lane; v2u* ob = (v2u*)(XN + (size_t)m2 * D) + F.lane; float sa = 0.f, sb = 0.f;
#pragma unroll
        for (int j = 0; j < 4; ++j) { sa += (va[j].x * va[j].x + va[j].y * va[j].y) + (va[j].z * va[j].z + va[j].w * va[j].w); sb += (vb[j].x * vb[j].x + vb[j].y * vb[j].y) + (vb[j].z * vb[j].z + vb[j].w * vb[j].w);
            const f32x4 ya = va[j] * (*((const f32x4*)sca + F.lane + 64 * j) + 1.0f), yb = vb[j] * (*((const f32x4*)scb + F.lane + 64 * j) + 1.0f);
            oa[64 * j] = (v2u){pk2(ya.x, ya.y), pk2(ya.z, ya.w)}; ob[64 * j] = (v2u){pk2(yb.x, yb.y), pk2(yb.z, yb.w)}; }
#pragma unroll
        for (int o = 1; o < 64; o <<= 1) { sa += shfl_i(sa, F.lane ^ o); sb += shfl_i(sb, F.lane ^ o); }
        if (F.lane == 0) { SS0[m] = sa; SS0[m2] = sb; }
    }
}

template <int NG> __device__ __forceinline__ void gates_pass(Frame& F, int l) {
    const int gw = F.vcu * NWAVES + F.wave, NGW = F.G * NWAVES;
    LAS float* wg = (LAS float*)F.lds;
    { const f32x4* src = (const f32x4*)((const float*)(F.ws + WS_PAR) + (NG == 8 ? PG_IN + l * 8192 : PG_KV)); for (int i = F.tid; i < NG * 256; i += 512) ((LAS f32x4*)wg)[i] = src[i]; }
    __syncthreads();
    const float* PAR = (const float*)(F.ws + WS_PAR);
    const bf16* A = (NG == 8) ? (const bf16*)(F.ws + WS_XN) : (const bf16*)(F.ws + WS_KVN);
    const float* SS = (const float*)(F.ws + WS_SS) + (size_t)(2 * l) * M;
    const float* shw = (const float*)(F.ws + WS_SHW) + SHW_IN + (size_t)l * 8 * A_PROJ + 3072;
    for (int m0 = gw; m0 < M; m0 += 2 * NGW) {
        asm volatile("" ::: "memory");
        const int m1 = (m0 + NGW < M) ? m0 + NGW : m0;
        const v2u* ar0 = (const v2u*)(A + (size_t)m0 * D) + F.lane; const v2u* ar1 = (const v2u*)(A + (size_t)m1 * D) + F.lane;
        f32x4 y0[4], y1[4];
#pragma unroll
        for (int j = 0; j < 4; ++j) { const v2u a = ar0[64 * j], b = ar1[64 * j]; y0[j] = (f32x4){bflo(a.x), bfhi(a.x), bflo(a.y), bfhi(a.y)}; y1[j] = (f32x4){bflo(b.x), bfhi(b.x), bflo(b.y), bfhi(b.y)}; }
        const float r0 = __builtin_amdgcn_rsqf(SS[m0] * (1.0f / D) + EPS), r1 = __builtin_amdgcn_rsqf(SS[m1] * (1.0f / D) + EPS);
        float pg0[NG], pg1[NG];
#pragma unroll
        for (int g = 0; g < NG; ++g) { float p = 0.f, q = 0.f;
#pragma unroll
            for (int j = 0; j < 4; ++j) { const f32x4 w = *((const LAS f32x4*)(wg + g * 1024) + F.lane + 64 * j);
                p += (y0[j].x * w.x + y0[j].y * w.y) + (y0[j].z * w.z + y0[j].w * w.w); q += (y1[j].x * w.x + y1[j].y * w.y) + (y1[j].z * w.z + y1[j].w * w.w); }
            pg0[g] = p; pg1[g] = q; }
#pragma unroll
        for (int o = 1; o < 64; o <<= 1) {
#pragma unroll
            for (int g = 0; g < NG; ++g) { pg0[g] += shfl_i(pg0[g], F.lane ^ o); pg1[g] += shfl_i(pg1[g], F.lane ^ o); } }
        float mine0 = 0.f, mine1 = 0.f;
#pragma unroll
        for (int g = 0; g < NG; ++g) if (F.lane == g) { mine0 = pg0[g]; mine1 = pg1[g]; }
#pragma unroll
        for (int rr = 0; rr < 2; ++rr) { const int m = rr ? m1 : m0; const float r = rr ? r1 : r0, mine = rr ? mine1 : mine0;
            if (rr == 1 && m1 == m0) break;
            if (NG == 8) {
                if (F.lane < 8) { const float pre = r * mine + shw[(size_t)(m >> 11) * A_PROJ + F.lane];
                    if (F.lane < 4) ((float*)(F.ws + WS_IG))[(size_t)m * 4 + F.lane] = pre + PAR[PBI + l * 4 + F.lane];
                    else ((float*)(F.ws + WS_LF))[(size_t)m * 4 + F.lane - 4] = logsigmoidf_(pre + PAR[PBF + l * 4 + F.lane - 4]); }
            } else {
                if (F.lane < 16) ((float*)(F.ws + WS_LF16))[(size_t)m * 16 + F.lane] = logsigmoidf_(r * mine + PAR[PFGB + F.lane]);
            } }
    }
    __syncthreads();
}
__device__ __forceinline__ void fox_cumsum(Frame& F) {
    const int gw = F.vcu * NWAVES + F.wave, NGW = F.G * NWAVES;
    const float* LF16 = (const float*)(F.ws + WS_LF16); float* F2 = (float*)(F.ws + WS_F2);
    for (int bh = gw; bh < BATCH * 16; bh += NGW) {
        const int b = bh >> 4, h = bh & 15; const float* src = LF16 + ((size_t)b * SEQ + 32 * F.lane) * 16 + h;
        float tot = 0.f;
        for (int i = 0; i < 32; ++i) tot += src[i * 16];
        float inc = tot;
#pragma unroll
        for (int o = 1; o < 64; o <<= 1) { const float t = shfl_i(inc, (F.lane - o) & 63); if (F.lane >= o) inc += t; }
        float run = inc - tot; float* dst = F2 + (size_t)bh * SEQ + 32 * F.lane;
        for (int i = 0; i < 32; ++i) { run += src[i * 16]; dst[i] = run * LOG2E; }
    }
}
__device__ __forceinline__ void final_phase(Frame& F) {
    const int gw = F.vcu * NWAVES + F.wave, NGW = F.G * NWAVES;
    const float* SS = (const float*)(F.ws + WS_SS) + (size_t)8 * M;
    for (int m0 = gw; m0 < M; m0 += 4 * NGW) {
        f32x4 v[4][4]; float rs[4]; int mr[4];
#pragma unroll
        for (int q = 0; q < 4; ++q) { mr[q] = (m0 + q * NGW < M) ? m0 + q * NGW : m0; const f32x4* xr = (const f32x4*)(F.X + (size_t)mr[q] * D) + F.lane;
#pragma unroll
            for (int j = 0; j < 4; ++j) v[q][j] = xr[64 * j];
            rs[q] = SS[mr[q]]; }
#pragma unroll
        for (int q = 0; q < 4; ++q) { if (q > 0 && mr[q] == m0) continue;
            const float r = __builtin_amdgcn_rsqf(rs[q] * (1.0f / D) + EPS); f32x4* xw = (f32x4*)(F.X + (size_t)mr[q] * D) + F.lane;
#pragma unroll
            for (int j = 0; j < 4; ++j) { const f32x4 gn = *((const f32x4*)((const float*)(F.ws + WS_PAR) + PFG) + F.lane + 64 * j); xw[64 * j] = v[q][j] * r * gn; } }
    }
}
__device__ __forceinline__ void mlstm_post(Frame& F, int l) {
    const int gw = F.vcu * NWAVES + F.wave, NGW = F.G * NWAVES;
    const bf16* HT = (const bf16*)(F.ws + WS_HT); const bf16* OA = (const bf16*)(F.ws + WS_OA); bf16* G = (bf16*)(F.ws + WS_G);
    const float* hg = (const float*)(F.ws + WS_PAR) + PHG + (size_t)l * 1024;
    for (int m = gw; m < M; m += NGW) {
        const v2u* hr = (const v2u*)(HT + (size_t)m * D) + F.lane; const v2u* orow = (const v2u*)(OA + (size_t)m * D) + F.lane; v2u* gr = (v2u*)(G + (size_t)m * D) + F.lane;
        v2u hv[4], ov[4]; float ssq[4];
#pragma unroll
        for (int j = 0; j < 4; ++j) { hv[j] = hr[64 * j]; ov[j] = orow[64 * j];
            const float h0 = bflo(hv[j].x), h1 = bfhi(hv[j].x), h2 = bflo(hv[j].y), h3 = bfhi(hv[j].y); ssq[j] = (h0 * h0 + h1 * h1) + (h2 * h2 + h3 * h3); }
#pragma unroll
        for (int o = 1; o < 64; o <<= 1) {
#pragma unroll
            for (int j = 0; j < 4; ++j) ssq[j] += shfl_i(ssq[j], F.lane ^ o); }
#pragma unroll
        for (int j = 0; j < 4; ++j) { const float h0 = bflo(hv[j].x), h1 = bfhi(hv[j].x), h2 = bflo(hv[j].y), h3 = bfhi(hv[j].y);
            const float r = __builtin_amdgcn_rsqf(ssq[j] * (1.0f / 256.0f) + EPS);
            const f32x4 gn = *((const f32x4*)hg + F.lane + 64 * j);
            gr[64 * j] = (v2u){pk2(bflo(ov[j].x) * h0 * r * gn.x, bfhi(ov[j].x) * h1 * r * gn.y), pk2(bflo(ov[j].y) * h2 * r * gn.z, bfhi(ov[j].y) * h3 * r * gn.w)}; }
    }
}

#define LDS_BARRIER() asm volatile("s_waitcnt lgkmcnt(0)\n\ts_barrier" ::: "memory")
typedef short s16x4_t __attribute__((ext_vector_type(4)));
__device__ __forceinline__ bf16x8 tr8(const LAS unsigned char* p0, const LAS unsigned char* p1) {
    const s16x4_t a = __builtin_bit_cast(s16x4_t, __builtin_amdgcn_ds_read_tr16_b64_v4i16((LAS s16x4_t*)p0)), b = __builtin_bit_cast(s16x4_t, __builtin_amdgcn_ds_read_tr16_b64_v4i16((LAS s16x4_t*)p1));
    return (bf16x8){a[0], a[1], a[2], a[3], b[0], b[1], b[2], b[3]};
}
__device__ __forceinline__ void mlstm_phase(Frame& F, int l) {
    constexpr int QP = 144, VP = 80, CP = 136, PP = 72;
    constexpr int OQ = 0, OK0 = 18432, OV = 3 * 18432, OVW0 = OV + 10240, OCT = OVW0 + 2 * 10240, OP = OCT + 48 * CP * 2;
    constexpr int OG = OP + 64 * PP * 2;
    constexpr int ORS = OG + 3 * 32 * 64 * 4;
    static_assert(ORS + 512 <= MISC_OFF, "mlstm LDS");
    LAS unsigned char* L = F.lds;
    const int tid = F.tid, lane = F.lane, w = F.wave, fr = lane & 15, fq = lane >> 4;
    const bf16* QA = (const bf16*)(F.ws + WS_QA); const bf16* KA = (const bf16*)(F.ws + WS_KA); const bf16* VA = (const bf16*)(F.ws + WS_VA); bf16* HT = (bf16*)(F.ws + WS_HT);
    const bf16* OAp = (const bf16*)(F.ws + WS_OA); float* HS = (float*)(F.ws + WS_HS) + (size_t)l * M * 4; const float* hgp = (const float*)(F.ws + WS_PAR) + PHG + (size_t)l * 1024;
    const float* IG = (const float*)(F.ws + WS_IG); const float* LF = (const float*)(F.ws + WS_LF);
    const int trq = (lane & 15) >> 2, trp = lane & 3;
    for (int item = F.vcu; item < 256; item += F.G) {
        const int b = item >> 5, h = (item >> 3) & 3, dvs = item & 7;
        const int gcol = h * 256 + dvs * 32 + 16 * (w & 1) + fr; const float gain = hgp[gcol];
        __syncthreads();
        for (int i = tid; i < 48 * CP / 2; i += 512) ((LAS unsigned*)(L + OCT))[i] = 0u;
        if (tid < 64) {
            LAS v4u* p = (LAS v4u*)(L + OV + tid * VP * 2 + 64); ((LAS unsigned*)p)[0] = 0x3f80u + (unsigned)(F.G >> 30);     ((LAS unsigned*)p)[1] = 0u; ((LAS unsigned*)p)[2] = 0u; ((LAS unsigned*)p)[3] = 0u; ((LAS unsigned*)p)[4] = 0u; ((LAS unsigned*)p)[5] = 0u; ((LAS unsigned*)p)[6] = 0u; ((LAS unsigned*)p)[7] = 0u;
            LAS v4u* p1 = (LAS v4u*)(L + OVW0 + tid * VP * 2 + 64); p1[0] = (v4u){0u, 0u, 0u, 0u}; p1[1] = (v4u){0u, 0u, 0u, 0u};
            LAS v4u* p2 = (LAS v4u*)(L + OVW0 + 10240 + tid * VP * 2 + 64); p2[0] = (v4u){0u, 0u, 0u, 0u}; p2[1] = (v4u){0u, 0u, 0u, 0u}; }
        f32x4 accC[3]; accC[0] = (f32x4){0.f, 0.f, 0.f, 0.f}; accC[1] = accC[0]; accC[2] = accC[0];
        float mst = 0.f;
        v4u nq[2], nk[2], nv = (v4u){0u, 0u, 0u, 0u};
#define ML_LOAD(t0_) do { _Pragma("unroll") for (int i = 0; i < 2; ++i) { const int p = tid + 512 * i; \
            nq[i] = *(const v4u*)(QA + ((t0_) + (p >> 4)) * 512 + h * 128 + (p & 15) * 8); nk[i] = *(const v4u*)(KA + ((t0_) + (p >> 4)) * 512 + h * 128 + (p & 15) * 8); } \
            if (w < 4) nv = *(const v4u*)(VA + ((t0_) + (tid >> 2)) * 1024 + h * 256 + dvs * 32 + (tid & 3) * 8); \
            } while (0)
        float g_u, g_M, g_wi, g_em, g_decay, g_ML, g_bL;
        {
          float pb[4], pu[4], pc[4];
#pragma unroll
          for (int q = 0; q < 4; ++q) { const size_t tk = (size_t)b * SEQ + (size_t)(w + 8 * q) * 64 + lane; pb[q] = LF[tk * 4 + h]; pu[q] = IG[tk * 4 + h]; }
#pragma unroll
          for (int o = 1; o < 64; o <<= 1) {
#pragma unroll
              for (int q = 0; q < 4; ++q) { const float t = shfl_i(pb[q], (lane - o) & 63); if (lane >= o) pb[q] += t; } }
#pragma unroll
          for (int q = 0; q < 4; ++q) { pu[q] -= pb[q]; pc[q] = pu[q]; }
#pragma unroll
          for (int o = 1; o < 64; o <<= 1) {
#pragma unroll
              for (int q = 0; q < 4; ++q) { const float t = shfl_i(pc[q], (lane - o) & 63); if (lane >= o) pc[q] = fmaxf(pc[q], t); } }
#pragma unroll
          for (int q = 0; q < 4; ++q) { LAS float* gp = (LAS float*)(L + OG) + (w + 8 * q) * 64 + lane; gp[0] = pb[q]; gp[2048] = pu[q]; gp[4096] = pc[q]; }
        }
        __syncthreads();
#define ML_STAGE(kb_, cn_) do { const LAS float* gp_ = (const LAS float*)(L + OG) + (cn_) * 64 + lane; const float bc = gp_[0]; g_u = gp_[2048]; const float cm = gp_[4096]; \
            g_M = fmaxf(mst, cm); g_ML = __int_as_float(__builtin_amdgcn_readlane(__float_as_int(g_M), 63)); g_bL = __int_as_float(__builtin_amdgcn_readlane(__float_as_int(bc), 63)); \
            const float wl = __expf(g_u - g_ML); g_decay = __expf(mst - g_ML); g_wi = __expf(mst - g_M); g_em = __expf(-(bc + g_M)); \
            _Pragma("unroll") for (int i = 0; i < 2; ++i) { const int p = tid + 512 * i; \
                *(LAS v4u*)(L + OQ + (p >> 4) * QP * 2 + (p & 15) * 16) = nq[i]; *(LAS v4u*)(L + OK0 + (kb_) * 18432 + (p >> 4) * QP * 2 + (p & 15) * 16) = nk[i]; } \
            if (w < 4) { const int row = tid >> 2; const float ws = shfl_i(wl, row); \
                *(LAS v4u*)(L + OV + row * VP * 2 + (tid & 3) * 16) = nv; \
                *(LAS v4u*)(L + OVW0 + (kb_) * 10240 + row * VP * 2 + (tid & 3) * 16) = (v4u){pk2(bflo(nv.x) * ws, bfhi(nv.x) * ws), pk2(bflo(nv.y) * ws, bfhi(nv.y) * ws), pk2(bflo(nv.z) * ws, bfhi(nv.z) * ws), pk2(bflo(nv.w) * ws, bfhi(nv.w) * ws)}; \
                if (w == 0) *(LAS bf16*)(L + OVW0 + (kb_) * 10240 + lane * VP * 2 + 64) = (bf16)f2bf(wl); } } while (0)
        { const size_t t0 = (size_t)b * SEQ; ML_LOAD(t0); }
        ML_STAGE(0, 0);
        unsigned short so[4];
#pragma unroll
        for (int r = 0; r < 4; ++r) so[r] = OAp[((size_t)b * SEQ + 16 * (w >> 1) + 4 * fq + r) * 1024 + gcol];
        for (int c = 0; c < SEQ / 64; ++c) {
            const int kb = c & 1; const size_t tok0 = (size_t)b * SEQ + (size_t)c * 64;
            const float decay = g_decay; const float mnew = g_bL + g_ML; const float mcur = mst;
            const int ti = w >> 1, ej = w & 1;
            float gb_t[4], gc_t[4], gu_s[2];
            { const LAS float* gt = (const LAS float*)(L + OG) + c * 64;
#pragma unroll
              for (int r = 0; r < 4; ++r) { gb_t[r] = gt[16 * ti + 4 * fq + r]; gc_t[r] = gt[4096 + 16 * ti + 4 * fq + r]; }
#pragma unroll
              for (int jj = 0; jj < 2; ++jj) gu_s[jj] = gt[2048 + 16 * (2 * (w & 1) + jj) + fr]; }
            if (c + 1 < SEQ / 64) { const size_t t1 = tok0 + 64; ML_LOAD(t1); }
            LDS_BARRIER();
#pragma unroll
            for (int jj = 0; jj < 2; ++jj) { const int sj = 2 * (w & 1) + jj; f32x4 acc = (f32x4){0.f, 0.f, 0.f, 0.f};
                if (sj <= ti) {
#pragma unroll
                    for (int ks = 0; ks < 4; ++ks) { const bf16x8 a = *(const LAS bf16x8*)(L + OQ + (16 * ti + fr) * QP * 2 + ks * 64 + fq * 16), bq = *(const LAS bf16x8*)(L + OK0 + kb * 18432 + (16 * sj + fr) * QP * 2 + ks * 64 + fq * 16);
                        acc = __builtin_amdgcn_mfma_f32_16x16x32_bf16(a, bq, acc, 0, 0, 0); } }
                const int s_ = 16 * sj + fr; const float us = gu_s[jj];
#pragma unroll
                for (int r = 0; r < 4; ++r) { const int t = 16 * ti + 4 * fq + r; const float e = __expf(fminf(us - fmaxf(mcur, gc_t[r]), 0.f));
                    *(LAS bf16*)(L + OP + t * PP * 2 + s_ * 2) = (bf16)f2bf(s_ <= t ? acc[r] * e : 0.f); } }
            LDS_BARRIER();
            f32x4 a1n = (f32x4){0.f, 0.f, 0.f, 0.f}, a1d = a1n, a2n = a1n, a2d = a1n;
#pragma unroll
            for (int ks = 0; ks < 4; ++ks) { const bf16x8 a = *(const LAS bf16x8*)(L + OQ + (16 * ti + fr) * QP * 2 + ks * 64 + fq * 16);
                const bf16x8 bn = *(const LAS bf16x8*)(L + OCT + (16 * ej + fr) * CP * 2 + ks * 64 + fq * 16), bd = *(const LAS bf16x8*)(L + OCT + (32 + fr) * CP * 2 + ks * 64 + fq * 16);
                a1n = __builtin_amdgcn_mfma_f32_16x16x32_bf16(a, bn, a1n, 0, 0, 0); a1d = __builtin_amdgcn_mfma_f32_16x16x32_bf16(a, bd, a1d, 0, 0, 0); }
#pragma unroll
            for (int ks = 0; ks < 2; ++ks) { const bf16x8 a = *(const LAS bf16x8*)(L + OP + (16 * ti + fr) * PP * 2 + ks * 64 + fq * 16);
                const LAS unsigned char* vb = L + OV + (32 * ks + 8 * fq + trq) * VP * 2 + trp * 8;
                const bf16x8 bn = tr8(vb + 32 * ej, vb + 4 * VP * 2 + 32 * ej), bd = tr8(vb + 64, vb + 4 * VP * 2 + 64);
                a2n = __builtin_amdgcn_mfma_f32_16x16x32_bf16(a, bn, a2n, 0, 0, 0); a2d = __builtin_amdgcn_mfma_f32_16x16x32_bf16(a, bd, a2d, 0, 0, 0); }
            asm volatile("s_waitcnt lgkmcnt(0)" ::: "memory");
            LDS_BARRIER();
            float q4[4];
#pragma unroll
            for (int r = 0; r < 4; ++r) { const int t = 16 * ti + 4 * fq + r; const float Mt_ = fmaxf(mcur, gc_t[r]); const float wit = __expf(mcur - Mt_), emt = __expf(-(gb_t[r] + Mt_));
                const float den = shfl_i(wit * a1d[r] + a2d[r], lane & 48);
                const float hv = (wit * a1n[r] + a2n[r]) * __builtin_amdgcn_rcpf(fmaxf(fabsf(den), emt));
                q4[r] = hv * hv; HT[(tok0 + t) * 1024 + gcol] = (bf16)f2bf(hv * bf1(so[r]) * gain); }
#pragma unroll
            for (int r = 0; r < 4; ++r) { float q = q4[r];
                q += __int_as_float(__builtin_amdgcn_mov_dpp(__float_as_int(q), 0xB1, 0xF, 0xF, true));
                q += __int_as_float(__builtin_amdgcn_mov_dpp(__float_as_int(q), 0x4E, 0xF, 0xF, true));
                q += __int_as_float(__builtin_amdgcn_mov_dpp(__float_as_int(q), 0x141, 0xF, 0xF, true));
                q += __int_as_float(__builtin_amdgcn_mov_dpp(__float_as_int(q), 0x140, 0xF, 0xF, true));
                q4[r] = q; }
            if (c + 1 < SEQ / 64) {
#pragma unroll
                for (int r = 0; r < 4; ++r) so[r] = OAp[(tok0 + 64 + 16 * ti + 4 * fq + r) * 1024 + gcol]; }
            { const float mq = fr == 0 ? q4[0] : fr == 1 ? q4[1] : fr == 2 ? q4[2] : q4[3];
              if (fr < 4) (void)__hip_atomic_fetch_add(HS + (size_t)h * M + tok0 + 16 * ti + 4 * fq + fr, mq, __ATOMIC_RELAXED, __HIP_MEMORY_SCOPE_AGENT); }
#pragma unroll
            for (int ks = 0; ks < 2; ++ks) { const LAS unsigned char* kbp = L + OK0 + kb * 18432 + (32 * ks + 8 * fq + trq) * QP * 2 + 32 * w + trp * 8;
                const bf16x8 bk = tr8(kbp, kbp + 4 * QP * 2);
                const LAS unsigned char* vwp = L + OVW0 + kb * 10240 + (32 * ks + 8 * fq + trq) * VP * 2 + trp * 8;
#pragma unroll
                for (int ei = 0; ei < 3; ++ei) { const bf16x8 av = tr8(vwp + 32 * ei, vwp + 4 * VP * 2 + 32 * ei);
                    if (ks == 0) accC[ei] = accC[ei] * decay;
                    accC[ei] = __builtin_amdgcn_mfma_f32_16x16x32_bf16(av, bk, accC[ei], 0, 0, 0); } }
#pragma unroll
            for (int ei = 0; ei < 3; ++ei)
#pragma unroll
                for (int r = 0; r < 4; ++r) *(LAS bf16*)(L + OCT + (16 * ei + 4 * fq + r) * CP * 2 + (16 * w + fr) * 2) = (bf16)f2bf(accC[ei][r]);
            mst = mnew;
            if (c + 1 < SEQ / 64) ML_STAGE(kb ^ 1, c + 1);
        }
#undef ML_LOAD
#undef ML_STAGE
    }
}

#ifndef PHMASK
#define PHMASK 0xffff
#endif
#define PH_EN(b) (((PHMASK) >> (b)) & 1)
__global__ void __launch_bounds__(NWAVES * 64, 2) yoco_fwd(Args args) {
    extern __shared__ __attribute__((aligned(16))) unsigned char lds[];
    Frame F;
    F.lds = (LAS unsigned char*)lds;
    const int wv0 = __builtin_amdgcn_readfirstlane((int)threadIdx.x >> 6);
    { const int t0_ = (wv0 << 6) + (int)__builtin_amdgcn_mbcnt_hi(~0u, __builtin_amdgcn_mbcnt_lo(~0u, 0u));
      volatile LAS unsigned* misc = (volatile LAS unsigned*)((LAS unsigned char*)lds + MISC_OFF); if (t0_ < 32) misc[t0_] = 0u;
      __syncthreads();
      (void)xcd_barrier_post((unsigned*)(args.ws + WS_BAR), (volatile LAS unsigned*)((LAS unsigned char*)lds + MISC_OFF) + 8, t0_); }
#ifdef PROBE_MASK
    unsigned long long tacc = 0ull;
#endif
#pragma nounroll
    for (int ph = args.ph_lo; ph < args.ph_hi; ++ph) {
#ifdef PROBE_MASK
        const unsigned long long tp0 = __builtin_amdgcn_s_memrealtime();
#endif
        { int zz = 0; asm volatile("" : "+s"(zz)); zz = __builtin_amdgcn_readfirstlane(zz);
          const int gx = (int)gridDim.x + zz, bx = (int)blockIdx.x + zz, tx = (wv0 << 6) + (int)__builtin_amdgcn_mbcnt_hi(~0u, __builtin_amdgcn_mbcnt_lo(~0u, (unsigned)zz));
          F.X = args.out + zz; F.ws = args.ws + zz; F.G = gx; F.bx = bx; F.vcu = (gx % 8 == 0) ? (bx % 8) * (gx / 8) + bx / 8 : bx;
          F.tid = tx; F.lane = tx & 63; F.wave = __builtin_amdgcn_readfirstlane(tx >> 6); }
        const float* MOD = (const float*)(F.ws + WS_MOD);
        bf16* XN = (bf16*)(F.ws + WS_XN);
        const float* SSb = (const float*)(F.ws + WS_SS); const float* SHW = (const float*)(F.ws + WS_SHW);
        if (ph == 0) p0_prologue(F, args);
        else if (ph == 1) p1_prologue(F, args);
        else if (ph == NPH - 1) final_phase(F);
        else {
            const int l = (ph - 2) / 6, sub = (ph - 2) % 6; const bool isA = l < NA;
            if (sub == 0) {
                if (isA) {
                    gates_pass<8>(F, l);
                    pg8::Gemm g{XN, (const bf16*)(F.ws + WS_WIN) + (size_t)l * 3072 * 1024, M, 3072, D}; pg8::StaticOrder S; S.init(M, 3072, F.G, F.bx);
                    pg8::EpiStore<0> E{(bf16*)(F.ws + WS_QA), (bf16*)(F.ws + WS_KA), (bf16*)(F.ws + WS_VA), (bf16*)(F.ws + WS_OA), SSb + (size_t)(2 * l) * M, SHW + SHW_IN + (size_t)l * 8 * A_PROJ, 0.08838834764831845f, A_PROJ};
                    pg8::gemm_phase<pg8::EpiStore<0>, pg8::StaticOrder, true, true>(F.lds, g, S, E, F.tid);
                } else {
                    if (l == NA) gates_pass<16>(F, l);
                    { pg8::Gemm g{XN, (const bf16*)(F.ws + WS_WQ) + (size_t)(l - NA) * 1024 * 1024, M, D, D}; pg8::StaticOrder S; S.init(M, D, F.G, F.bx);
                      pg8::EpiStore<1> E{(bf16*)(F.ws + WS_QO), nullptr, nullptr, nullptr, SSb + (size_t)(2 * l) * M, SHW + SHW_Q + (size_t)(l - NA) * 8 * 1024, 0.18033688011112042f, 1024};
                      pg8::gemm_phase<pg8::EpiStore<1>, pg8::StaticOrder, true, true>(F.lds, g, S, E, F.tid); }
                    if (l == NA) { pg8::Gemm g{(const bf16*)(F.ws + WS_KVN), (const bf16*)(F.ws + WS_WKV), M, 2048, D}; pg8::StaticOrder S; S.init(M, 2048, F.G, F.bx);
                      pg8::EpiStore<2> E{(bf16*)(F.ws + WS_KF), (bf16*)(F.ws + WS_VF), nullptr, nullptr, SSb + (size_t)(2 * l) * M, nullptr, 1.f, 0};
                      pg8::gemm_phase<pg8::EpiStore<2>, pg8::StaticOrder, true, true>(F.lds, g, S, E, F.tid); }
                }
            }
            else if (sub == 1) { if (isA) mlstm_phase(F, l); else continue; }
            else if (sub == 2) {
                if (isA) continue;
                else { const attn_body::AttnTensors AT{(const attn_body::bf16*)(F.ws + WS_QO), (const attn_body::bf16*)(F.ws + WS_KF), (const attn_body::bf16*)(F.ws + WS_VF), (attn_body::bf16*)(F.ws + WS_QO), (const float*)(F.ws + WS_LF16)};
                    const attn_body::StaticOrder S((int)F.G, F.vcu);
#ifdef ATTN_EXP
#pragma nounroll
                    for (int rep_ = 0; rep_ < 2; ++rep_) {
                        const attn_body::AttnTensors AD{(const attn_body::bf16*)(F.ws + WS_QO), (const attn_body::bf16*)(F.ws + WS_KF), (const attn_body::bf16*)(F.ws + WS_VF), (attn_body::bf16*)(F.ws + (rep_ ? WS_QO : WS_KVN)), (const float*)(F.ws + WS_LF16)};
                        const attn_body::StaticOrder S2((int)F.G, F.vcu, (rep_ == 0 && ATTN_EXP >= 10) ? ATTN_EXP - 10 : -1);
                        attn_body::attn_phase<attn_body::StaticOrder>((char*)lds, AD, S2, F.tid, rep_ == 0 && ATTN_EXP == 1); }
                    }
#else
                    attn_body::attn_phase<attn_body::StaticOrder>((char*)lds, AT, S, F.tid); }
#endif
            }
            else if (sub == 3 || sub == 5) {
                const bool dn = (sub == 5);
                const bf16* A = dn ? (const bf16*)(F.ws + WS_H) : (isA ? (const bf16*)(F.ws + WS_HT) : (const bf16*)(F.ws + WS_QO));
                const bf16* Bt = dn ? (const bf16*)(F.ws + WS_W2) + (size_t)l * 1024 * 4096 : (isA ? (const bf16*)(F.ws + WS_WAO) + (size_t)l * 1024 * 1024 : (const bf16*)(F.ws + WS_WBO) + (size_t)(l - NA) * 1024 * 1024);
                pg8::Gemm g{A, Bt, M, D, dn ? FF : D}; pg8::StaticOrder S; S.init(M, D, F.G, F.bx);
                const bool last = dn && (l == DEPTH - 1);
                const float* xin_ = (ph == 5) ? args.in[I_X] : (const float*)F.X;
                pg8::EpiRes E{xin_, F.X, MOD + (size_t)l * 8 * 6144 + (dn ? 5 : 2) * 1024,
                              (float*)(F.ws + WS_SS) + (size_t)(2 * l + (dn ? 2 : 1)) * M, last ? (bf16*)nullptr : XN,
                              dn ? MOD + (size_t)(l + 1) * 8 * 6144 + 1024 : MOD + (size_t)l * 8 * 6144 + 4 * 1024,
                              (dn && l == NA - 1) ? (bf16*)(F.ws + WS_KVN) : (bf16*)nullptr, (const float*)(F.ws + WS_PAR) + PKVG,
                              (isA && !dn) ? (const float*)(F.ws + WS_HS) + (size_t)l * M * 4 : (const float*)nullptr};
                pg8::gemm_phase<pg8::EpiRes, pg8::StaticOrder, true, true>(F.lds, g, S, E, F.tid);
            }
            else {
                pg8::Gemm g{XN, (const bf16*)(F.ws + WS_W1) + (size_t)l * 1024 * 4096, M, FF, D}; pg8::StaticOrder S; S.init(M, FF, F.G, F.bx);
                pg8::EpiStore<3> E{(bf16*)(F.ws + WS_H), nullptr, nullptr, nullptr, SSb + (size_t)(2 * l + 1) * M, SHW + SHW_UP + (size_t)l * 8 * 4096, 1.f, 4096};
                pg8::gemm_phase<pg8::EpiStore<3>, pg8::StaticOrder, true, true>(F.lds, g, S, E, F.tid);
            }
        }
        if (ph + 1 < args.ph_hi) { XcdBarrier bar; bar.bar = (unsigned*)(F.ws + WS_BAR); bar.x = xb_xcc_id(); bar.st = (volatile LAS unsigned*)(F.lds + MISC_OFF) + 8; xcd_barrier(bar, F.tid);
#ifdef EXTRA_BAR
            for (int eb_ = 0; eb_ < EXTRA_BAR; ++eb_) xcd_barrier(bar, F.tid);
#endif
        }
#ifdef PROBE_MASK
        { const int pb = (ph == 0) ? 8 : (ph == 1) ? 10 : (ph == NPH - 1) ? 9 : (((ph - 2) % 6) + ((ph - 2) / 6 >= NA ? 12 : 0)); if (((PROBE_MASK) >> pb) & 1) tacc += __builtin_amdgcn_s_memrealtime() - tp0; }
#endif
    }
#ifdef PROBE_MASK
    if (blockIdx.x == 0 && wv0 == 0 && __builtin_amdgcn_mbcnt_lo(~0u, 0u) == 0u) { const unsigned long long t0 = __builtin_amdgcn_s_memrealtime(); while (__builtin_amdgcn_s_memrealtime() - t0 < tacc) __builtin_amdgcn_s_sleep(16); }
#endif
}

#ifndef MK_N_LAUNCHES
#define MK_N_LAUNCHES 1
#endif
extern "C" void kernel_launch(void* const* d_in, const int* in_sizes, int n_in, void* d_out, int out_size, void* d_ws, size_t ws_size, hipStream_t stream) {
    static int grid = 0;
    if (grid == 0) {
        if (n_in != 17 || out_size != M * D || ws_size < WS_END) { fprintf(stderr, "kernel_launch: unexpected shapes: n_in %d out %d ws %zu\n", n_in, out_size, ws_size); grid = -1; return; }
        int dev = 0, cus = 0, per_cu = 0;
        if (hipGetDevice(&dev) != hipSuccess || hipDeviceGetAttribute(&cus, hipDeviceAttributeMultiprocessorCount, dev) != hipSuccess) { grid = -1; return; }
        if (hipFuncSetAttribute((const void*)yoco_fwd, hipFuncAttributeMaxDynamicSharedMemorySize, LDS_BYTES) != hipSuccess) { fprintf(stderr, "kernel_launch: hipFuncSetAttribute failed\n"); grid = -1; return; }
        if (hipOccupancyMaxActiveBlocksPerMultiprocessor(&per_cu, (const void*)yoco_fwd, NWAVES * 64, LDS_BYTES) != hipSuccess || per_cu < 1) { fprintf(stderr, "kernel_launch: occupancy query says %d\n", per_cu); per_cu = 1; }
        (void)hipGetLastError();
        grid = cus;
    }
    if (grid < 0) return;
    if (hipMemsetAsync((char*)d_ws + WS_BAR, 0, WS_BAR_BYTES, stream) != hipSuccess) { fprintf(stderr, "kernel_launch: memset failed\n"); return; }
    Args a{};
    for (int i = 0; i < 17; ++i) a.in[i] = (const float*)d_in[i];
    a.out = (float*)d_out; a.ws = (unsigned char*)d_ws;
#if MK_N_LAUNCHES == 1
    a.ph_lo = 0; a.ph_hi = NPH;
    void* kargs[] = {&a};
    hipError_t e = hipLaunchCooperativeKernel((const void*)yoco_fwd, dim3(grid), dim3(NWAVES * 64), kargs, LDS_BYTES, stream);
    if (e != hipSuccess) fprintf(stderr, "kernel_launch: cooperative launch failed: %s (grid %d)\n", hipGetErrorString(e), grid);
#else
    for (int ph = 0; ph < NPH; ++ph) { a.ph_lo = ph; a.ph_hi = ph + 1; hipLaunchKernelGGL(yoco_fwd, dim3(grid), dim3(NWAVES * 64), LDS_BYTES, stream, a); }
#endif
}
```
